# Optimizing an MI355X kernel written in HIP

```python
import math
import numpy as np
import jax
import jax.numpy as jnp
from jax import lax

D_MODEL = 2048
BATCH = 2
SEQ = 16384
DEPTH = 1

CTX_LEN = 256
GRID_W = 64

MLA_HEADS = 8
MLA_Q_RANK = 512
MLA_KV_RANK = 512
MLA_NOPE = 128
MLA_ROPE = 64
MLA_V = 128
MLA_QK = MLA_NOPE + MLA_ROPE
ROPE_BASE = 10000.0
Q_BLOCK = 128

DN_HEADS = 8
DN_DK = 128
DN_DV = 128
DN_CONV = 3
DN_CHUNK = 64

FFN_HIDDEN = 5504
FFN_CONV = 3

EPS = 1e-6

IN_SPLITS = (MLA_Q_RANK, MLA_KV_RANK, MLA_ROPE,
             DN_HEADS * DN_DK, DN_HEADS * DN_DK, DN_HEADS * DN_DV, DN_HEADS * DN_DV,
             2 * DN_HEADS, 2 * DN_HEADS, D_MODEL, D_MODEL)
IN_WIDTH = sum(IN_SPLITS)

kernel_name = 'hybrid_mla_gdn_convglu_dit'


def rmsnorm(x, w):
    xf = x.astype(jnp.float32)
    y = xf * lax.rsqrt(jnp.mean(xf * xf, axis=-1, keepdims=True) + EPS)
    return (y * w.astype(jnp.float32)).astype(x.dtype)


def l2norm(x):
    xf = x.astype(jnp.float32)
    return xf * lax.rsqrt(jnp.sum(xf * xf, axis=-1, keepdims=True) + EPS)


def modulate(x, shift, scale):
    return x * (1 + jnp.expand_dims(scale, -2)) + jnp.expand_dims(shift, -2)


def dwconv_centred(x, w):
    k = w.shape[0]
    p = k // 2
    t = x.shape[1]
    xp = jnp.pad(x, ((0, 0), (p, p), (0, 0)))
    return sum(xp[:, j:j + t] * w[j] for j in range(k))


def split_columns(p):
    offs = np.cumsum(np.array(IN_SPLITS))[:-1].tolist()
    return jnp.split(p, offs, axis=-1)


def axial_rope_tables(rows, dtype):
    n = MLA_ROPE // 4
    row = jnp.repeat(jnp.arange(rows, dtype=jnp.float32), GRID_W)
    col = jnp.tile(jnp.arange(GRID_W, dtype=jnp.float32), rows)
    inv = ROPE_BASE ** (-jnp.arange(n, dtype=jnp.float32) / n)
    ang_r = row[:, None, None] * inv
    ang_c = col[:, None, None] * inv
    return tuple(a.astype(dtype) for a in (jnp.cos(ang_r), jnp.sin(ang_r), jnp.cos(ang_c), jnp.sin(ang_c)))


def rotate_pairs(x, cos, sin):
    a, b = jnp.split(x, 2, axis=-1)
    return jnp.concatenate([a * cos - b * sin, b * cos + a * sin], axis=-1)


def apply_axial_rope(t, tabs):
    cos_r, sin_r, cos_c, sin_c = tabs
    nope, rr, rc = jnp.split(t, [MLA_NOPE, MLA_NOPE + MLA_ROPE // 2], axis=-1)
    return jnp.concatenate([nope, rotate_pairs(rr, cos_r, sin_r), rotate_pairs(rc, cos_c, sin_c)], axis=-1)


def mla_q(q_a, q_a_norm, w_q_b, q_norm, tabs):
    b, t, _ = q_a.shape
    q = (rmsnorm(q_a, q_a_norm) @ w_q_b).reshape(b, t, MLA_HEADS, MLA_QK)
    q = rmsnorm(q, q_norm)
    return q if tabs is None else apply_axial_rope(q, tabs)


def mla_kv(kv_a, k_rope, kv_a_norm, w_kv_b, k_norm, tabs):
    b, t, _ = kv_a.shape
    kv = (rmsnorm(kv_a, kv_a_norm) @ w_kv_b).reshape(b, t, MLA_HEADS, MLA_NOPE + MLA_V)
    k_nope, v = jnp.split(kv, [MLA_NOPE], axis=-1)
    k_r = jnp.broadcast_to(k_rope[:, :, None, :], (b, t, MLA_HEADS, MLA_ROPE))
    k = rmsnorm(jnp.concatenate([k_nope, k_r], axis=-1), k_norm)
    k = k if tabs is None else apply_axial_rope(k, tabs)
    return k, v


def attend_dense(q, k, v):
    b, n, h, _ = q.shape
    s = jnp.einsum('bqhd,bkhd->bhqk', q, k).astype(jnp.float32) * (MLA_QK ** -0.5)
    p = jax.nn.softmax(s, axis=-1).astype(v.dtype)
    return jnp.einsum('bhqk,bkhd->bqhd', p, v).reshape(b, n, h * MLA_V)


def attend_latent(q, k_lat, v_lat, k_ctx, v_ctx):
    b, t, h, dq = q.shape
    nb = t // Q_BLOCK
    qb = q.reshape(b, nb, Q_BLOCK, h, dq).transpose(1, 0, 2, 3, 4)

    def block(qi):
        s = jnp.concatenate([jnp.einsum('bqhd,bkhd->bhqk', qi, k_lat),
                             jnp.einsum('bqhd,bkhd->bhqk', qi, k_ctx)], axis=-1)
        p = jax.nn.softmax(s.astype(jnp.float32) * (MLA_QK ** -0.5), axis=-1).astype(v_lat.dtype)
        return (jnp.einsum('bhqk,bkhd->bqhd', p[..., :t], v_lat)
                + jnp.einsum('bhqk,bkhd->bqhd', p[..., t:], v_ctx))

    o = lax.map(block, qb)
    return o.transpose(1, 0, 2, 3, 4).reshape(b, t, h * MLA_V)


def dn_prepare(dq, dk, dv, da, db, conv_w, a_log, dt_bias, need_q):
    b, t, _ = dk.shape
    wq, wk, wv = jnp.split(conv_w, [DN_HEADS * DN_DK, 2 * DN_HEADS * DN_DK], axis=-1)

    def conv_heads(a, w, d):
        return jax.nn.silu(dwconv_centred(a, w)).reshape(b, t, DN_HEADS, d).transpose(0, 2, 1, 3)

    k = l2norm(conv_heads(dk, wk, DN_DK))
    v = conv_heads(dv, wv, DN_DV).astype(jnp.float32)
    q = l2norm(conv_heads(dq, wq, DN_DK)) * (DN_DK ** -0.5) if need_q else None
    g = -jnp.exp(a_log.astype(jnp.float32)) * jax.nn.softplus(
        da.reshape(b, t, 2, DN_HEADS).astype(jnp.float32) + dt_bias.astype(jnp.float32))
    beta = jax.nn.sigmoid(db.reshape(b, t, 2, DN_HEADS).astype(jnp.float32))
    return q, k, v, g.transpose(2, 0, 3, 1), beta.transpose(2, 0, 3, 1)


def gated_delta_chunked(q, k, v, g, beta, s0, with_out):
    b, h, t, dk = k.shape
    dv = v.shape[-1]
    c = DN_CHUNK
    nc = t // c
    k = k.reshape(b, h, nc, c, dk)
    v = v.reshape(b, h, nc, c, dv)
    gc = jnp.cumsum(g.reshape(b, h, nc, c), axis=-1)
    beta = beta.reshape(b, h, nc, c, 1)
    incl = jnp.tril(jnp.ones((c, c), dtype=bool))
    strict = jnp.tril(jnp.ones((c, c), dtype=bool), -1)
    decay = jnp.exp(jnp.where(incl, gc[..., :, None] - gc[..., None, :], -jnp.inf))
    kb = k * beta
    m = jnp.where(strict, jnp.einsum('bhnid,bhnjd->bhnij', kb, k) * decay, 0.0)
    rhs = jnp.concatenate([v * beta, kb * jnp.exp(gc)[..., None]], axis=-1)
    sol = lax.linalg.triangular_solve(m + jnp.eye(c, dtype=m.dtype), rhs,
                                      left_side=True, lower=True, unit_diagonal=True)
    u, w = sol[..., :dv], sol[..., dv:]
    k_end = k * jnp.exp(gc[..., -1:] - gc)[..., None]
    g_end = jnp.exp(gc[..., -1])[..., None, None]
    xs = [u, w, k_end, g_end]
    if with_out:
        q = q.reshape(b, h, nc, c, dk)
        xs += [q * jnp.exp(gc)[..., None], jnp.einsum('bhnid,bhnjd->bhnij', q, k) * decay]
    xs = [jnp.moveaxis(a, 2, 0) for a in xs]

    def step(s, inp):
        u_c, w_c, k_c, g_c = inp[:4]
        v_new = u_c - jnp.einsum('bhcd,bhde->bhce', w_c, s)
        s_next = s * g_c + jnp.einsum('bhcd,bhce->bhde', k_c, v_new)
        if not with_out:
            return s_next, None
        q_c, a_c = inp[4:]
        o = jnp.einsum('bhcd,bhde->bhce', q_c, s) + jnp.einsum('bhcj,bhje->bhce', a_c, v_new)
        return s_next, o

    s_final, o = lax.scan(step, s0, xs)
    if not with_out:
        return None, s_final
    return jnp.moveaxis(o, 0, 2).reshape(b, h, t, dv), s_final


def dn_bidirectional(q, k, v, g, beta, s0, with_out):
    def flip(a):
        return None if a is None else jnp.flip(a, axis=2)

    o_f, s_f = gated_delta_chunked(q, k, v, g[0], beta[0], s0[0], with_out)
    o_b, s_b = gated_delta_chunked(flip(q), flip(k), flip(v), flip(g[1]), flip(beta[1]), s0[1], with_out)
    states = jnp.stack([s_f, s_b])
    if not with_out:
        return None, states
    return o_f + flip(o_b), states


def dn_output(o, z, o_norm, dtype):
    b, h, t, dv = o.shape
    y = rmsnorm(o.transpose(0, 2, 1, 3), o_norm) * jax.nn.silu(z.reshape(b, t, h, dv).astype(jnp.float32))
    return y.reshape(b, t, h * dv).astype(dtype)


def merge_branches(y_mla, y_dn, gate_mla, gate_dn, w_o_mla, w_o_dn, w_out):
    merged = jax.nn.sigmoid(gate_mla) * (y_mla @ w_o_mla) + jax.nn.sigmoid(gate_dn) * (y_dn @ w_o_dn)
    return merged @ w_out


def conv_glu(h, w_up, conv_w, w_down):
    gate, val = jnp.split(h @ w_up, 2, axis=-1)
    return (jax.nn.silu(dwconv_centred(gate, conv_w)) * val) @ w_down


def setup_inputs(seed: int = 0) -> dict:
    key = jax.random.key(seed)
    ks = jax.random.split(key, 32)
    L, D, H = DEPTH, D_MODEL, DN_HEADS
    f32 = jnp.float32

    def nrm(i, shape, scale):
        return jax.random.normal(ks[i], shape, f32) * scale

    def gain(i, n):
        return 1.0 + 0.01 * jax.random.normal(ks[i], (L, n), f32)

    dt = jnp.exp(jax.random.uniform(ks[20], (L, 2, H), f32, math.log(1e-3), math.log(1e-1)))
    dt_bias = dt + jnp.log(-jnp.expm1(-dt))
    a_log = jnp.log(jax.random.uniform(ks[21], (L, 2, H), f32, 1.0, 16.0))
    return {
        'x': nrm(0, (BATCH, SEQ, D), 1.0),
        'c': nrm(1, (BATCH, D), 1.0),
        'ctx': nrm(2, (BATCH, CTX_LEN, D), 1.0),
        'c_ctx': nrm(3, (D,), 1.0),
        'w_ada': nrm(4, (L, D, 6 * D), 0.5 * D ** -0.5),
        'b_ada': nrm(5, (L, 6 * D), 0.01),
        'norm_mix': gain(6, D),
        'w_in': nrm(7, (L, D, IN_WIDTH), D ** -0.5),
        'q_a_norm': gain(8, MLA_Q_RANK),
        'w_q_b': nrm(9, (L, MLA_Q_RANK, MLA_HEADS * MLA_QK), MLA_Q_RANK ** -0.5),
        'kv_a_norm': gain(10, MLA_KV_RANK),
        'w_kv_b': nrm(11, (L, MLA_KV_RANK, MLA_HEADS * (MLA_NOPE + MLA_V)), MLA_KV_RANK ** -0.5),
        'q_norm': gain(12, MLA_QK),
        'k_norm': gain(13, MLA_QK),
        'w_o_mla': nrm(14, (L, MLA_HEADS * MLA_V, D), (MLA_HEADS * MLA_V) ** -0.5),
        'dn_conv': nrm(15, (L, DN_CONV, DN_HEADS * (2 * DN_DK + DN_DV)), DN_CONV ** -0.5),
        'dn_a_log': a_log,
        'dn_dt_bias': dt_bias,
        'dn_o_norm': gain(16, DN_DV),
        'w_o_dn': nrm(17, (L, DN_HEADS * DN_DV, D), (DN_HEADS * DN_DV) ** -0.5),
        'w_out': nrm(18, (L, D, D), D ** -0.5),
        'norm_ffn': gain(19, D),
        'w_ffn_up': nrm(22, (L, D, 2 * FFN_HIDDEN), D ** -0.5),
        'ffn_conv': nrm(23, (L, FFN_CONV, FFN_HIDDEN), FFN_CONV ** -0.5),
        'w_ffn_down': nrm(24, (L, FFN_HIDDEN, D), FFN_HIDDEN ** -0.5),
    }


def reference(x, c, ctx, c_ctx, w_ada, b_ada, norm_mix, w_in, q_a_norm, w_q_b, kv_a_norm, w_kv_b,
              q_norm, k_norm, w_o_mla, dn_conv, dn_a_log, dn_dt_bias, dn_o_norm, w_o_dn, w_out,
              norm_ffn, w_ffn_up, ffn_conv, w_ffn_down):
    b, t, _ = x.shape
    rows = t // GRID_W
    tabs = axial_rope_tables(rows, x.dtype)
    s_zero = jnp.zeros((2, b, DN_HEADS, DN_DK, DN_DV), jnp.float32)
    for l in range(DEPTH):
        last = l == DEPTH - 1
        sh1, sc1, g1, sh2, sc2, g2 = jnp.split(jax.nn.silu(c) @ w_ada[l] + b_ada[l], 6, axis=-1)
        csh1, csc1, cg1, csh2, csc2, cg2 = jnp.split(jax.nn.silu(c_ctx) @ w_ada[l] + b_ada[l], 6, axis=-1)

        (lq_a, lkv_a, lk_r, ldq, ldk, ldv, ldz, lda, ldb, lga, lgb) = split_columns(
            modulate(rmsnorm(x, norm_mix[l]), sh1, sc1) @ w_in[l])
        (cq_a, ckv_a, ck_r, cdq, cdk, cdv, cdz, cda, cdb, cga, cgb) = split_columns(
            modulate(rmsnorm(ctx, norm_mix[l]), csh1, csc1) @ w_in[l])

        k_c, v_c = mla_kv(ckv_a, ck_r, kv_a_norm[l], w_kv_b[l], k_norm[l], None)
        k_l, v_l = mla_kv(lkv_a, lk_r, kv_a_norm[l], w_kv_b[l], k_norm[l], tabs)
        q_l = mla_q(lq_a, q_a_norm[l], w_q_b[l], q_norm[l], tabs)
        y_mla_l = attend_latent(q_l, k_l, v_l, k_c, v_c)

        cq, ck, cv, cgd, cbeta = dn_prepare(cdq, cdk, cdv, cda, cdb, dn_conv[l], dn_a_log[l], dn_dt_bias[l], not last)
        o_dn_c, s_ctx = dn_bidirectional(cq, ck, cv, cgd, cbeta, s_zero, not last)
        lq, lk, lv, lgd, lbeta = dn_prepare(ldq, ldk, ldv, lda, ldb, dn_conv[l], dn_a_log[l], dn_dt_bias[l], True)
        o_dn_l, _ = dn_bidirectional(lq, lk, lv, lgd, lbeta, s_ctx, True)

        y_l = merge_branches(y_mla_l, dn_output(o_dn_l, ldz, dn_o_norm[l], x.dtype), lga, lgb,
                             w_o_mla[l], w_o_dn[l], w_out[l])

        if not last:
            q_c = mla_q(cq_a, q_a_norm[l], w_q_b[l], q_norm[l], None)
            y_c = merge_branches(attend_dense(q_c, k_c, v_c), dn_output(o_dn_c, cdz, dn_o_norm[l], ctx.dtype),
                                 cga, cgb, w_o_mla[l], w_o_dn[l], w_out[l])
            ctx = ctx + jnp.expand_dims(cg1, -2) * y_c
            ctx = ctx + jnp.expand_dims(cg2, -2) * conv_glu(
                modulate(rmsnorm(ctx, norm_ffn[l]), csh2, csc2), w_ffn_up[l], ffn_conv[l], w_ffn_down[l])

        x = x + jnp.expand_dims(g1, -2) * y_l

        x = x + jnp.expand_dims(g2, -2) * conv_glu(
            modulate(rmsnorm(x, norm_ffn[l]), sh2, sc2), w_ffn_up[l], ffn_conv[l], w_ffn_down[l])
    return x
```

```cpp
#include <hip/hip_runtime.h>
#include <hip/hip_cooperative_groups.h>
#include <cstdio>
#include <cstdint>
namespace cg = cooperative_groups;

#ifndef DBG
#define DBG 0
#endif
#ifndef REP
#define REP -1
#endif
#ifndef N_LAUNCH_PER_PHASE
#define N_LAUNCH_PER_PHASE 0
#endif

#define LAS __attribute__((address_space(3)))
typedef unsigned short bf16_t;
typedef short bf16x8 __attribute__((ext_vector_type(8)));
typedef short s16x4 __attribute__((ext_vector_type(4)));
typedef float f32x4 __attribute__((ext_vector_type(4)));
typedef float f32x16 __attribute__((ext_vector_type(16)));
typedef unsigned u32x4 __attribute__((ext_vector_type(4)));
typedef unsigned u32x2 __attribute__((ext_vector_type(2)));

constexpr float EPS = 1e-6f;
constexpr size_t NROW = 33280, NLAT = 32768;
constexpr int LDS_BYTES = 143360;
constexpr int NPHASE = 15;

constexpr size_t O_MOD  = 0;
constexpr size_t O_BAR  = 147456;
constexpr size_t O_WIN  = 262144;
constexpr size_t O_WQB  = O_WIN  + 9472ull * 2048 * 2;
constexpr size_t O_WKVB = O_WQB  + 1536ull * 512 * 2;
constexpr size_t O_WCAT = O_WKVB + 2048ull * 512 * 2;
constexpr size_t O_WOUT = O_WCAT + 2048ull * 2048 * 2;
constexpr size_t O_WUP  = O_WOUT + 2048ull * 2048 * 2;
constexpr size_t O_WDN  = O_WUP  + 11008ull * 2048 * 2;
constexpr size_t O_XN   = O_WDN  + 2048ull * 5504 * 2;
constexpr size_t O_QN   = O_XN;
constexpr size_t O_KN   = O_XN + NROW * 1024 * 2;
constexpr size_t O_QKVA = O_XN + NROW * 2048 * 2;
constexpr size_t O_ACH  = O_QKVA + NROW * 1024 * 2;
constexpr size_t O_DQKV = O_ACH + NROW * 1024 * 2;
constexpr size_t O_VN   = O_DQKV + NROW * 3072 * 2;
constexpr size_t O_ZG   = O_VN + NROW * 1024 * 2;
constexpr size_t O_MISC = O_ZG + NROW * 5120 * 2;
constexpr size_t O_G    = O_MISC + NROW * 96 * 4;
constexpr size_t O_BETA = O_G + 2ull * 2 * 8 * 16640 * 4;
constexpr size_t O_GC   = O_BETA + 2ull * 2 * 8 * 16640 * 4;
constexpr size_t O_RSTD = O_GC + 2ull * 2 * 8 * 16640 * 4;
constexpr size_t O_UC   = O_RSTD + NROW * 2 * 4;
constexpr size_t O_WC   = O_UC + 2ull * 2 * 256 * 1024 * 2;
constexpr size_t O_END  = O_WC + 2ull * 2 * 256 * 1024 * 2;
constexpr size_t O_OSC   = O_DQKV;
constexpr size_t O_KVRAW = O_OSC + 2ull * 32768 * 1024 * 2;
constexpr size_t O_Q = O_XN + 1572864;
constexpr size_t O_K = O_Q + 2ull * 8 * 16384 * 192 * 2;
constexpr size_t O_V = O_K + 2ull * 8 * 16640 * 192 * 2;
constexpr size_t O_MERGED = O_DQKV;
constexpr size_t O_XN2 = O_XN;
constexpr size_t O_H = O_QKVA;
constexpr size_t O_SIDE = O_H + NLAT * 5504 * 2;
static_assert(O_KVRAW + NROW * 2048 * 2 <= O_ZG, "raw overlay");
static_assert(O_V + 2ull * 8 * 16640 * 128 * 2 <= O_DQKV && O_V >= O_ACH, "qkv overlay");
static_assert(O_SIDE + 2ull * 512 * 3 * 5504 * 4 <= O_END, "h overlay");
constexpr size_t DO_YCAT = 2ull * 32768 * 1024 * 2;

struct P { const float* in[25]; float* out; char* ws; };
typedef const __attribute__((address_space(4))) P CP;
enum { I_X = 0, I_C, I_CTX, I_CCTX, I_WADA, I_BADA, I_NMIX, I_WIN, I_QAN, I_WQB, I_KVAN, I_WKVB, I_QN, I_KNORM, I_WOMLA, I_DNCONV, I_ALOG, I_DTB, I_ONORM, I_WODN, I_WOUT, I_NFFN, I_WUP, I_FCONV, I_WDOWN };

__device__ __forceinline__ int lane_id_v() { int r; asm volatile("v_mbcnt_lo_u32_b32 %0, -1, 0\n\tv_mbcnt_hi_u32_b32 %0, -1, %0" : "=v"(r)); return r; }
#define TIDX (wv_ * 64 + lane_id_v())
typedef __bf16 bf16v2_t __attribute__((ext_vector_type(2)));
typedef float f32v2_t __attribute__((ext_vector_type(2)));
__device__ __forceinline__ unsigned cvtpk(float lo, float hi) { const f32v2_t v = {lo, hi}; const bf16v2_t r = __builtin_convertvector(v, bf16v2_t); return __builtin_bit_cast(unsigned, r); }
__device__ __forceinline__ float bflo(unsigned w) { return __uint_as_float(w << 16); }
__device__ __forceinline__ float bfhi(unsigned w) { return __uint_as_float(w & 0xffff0000u); }
__device__ __forceinline__ float bf2f(bf16_t v) { return __uint_as_float(((unsigned)v) << 16); }
__device__ __forceinline__ bf16_t f2bf(float f) { return (bf16_t)(cvtpk(f, 0.f) & 0xffffu); }
__device__ __forceinline__ float silu_f(float x) { return x * __builtin_amdgcn_rcpf(1.f + __expf(-x)); }
__device__ __forceinline__ float sigmoid_f(float x) { return __builtin_amdgcn_rcpf(1.f + __expf(-x)); }
__device__ __forceinline__ void unpack8(u32x4 w, float* f) { f[0] = bflo(w.x); f[1] = bfhi(w.x); f[2] = bflo(w.y); f[3] = bfhi(w.y); f[4] = bflo(w.z); f[5] = bfhi(w.z); f[6] = bflo(w.w); f[7] = bfhi(w.w); }
__device__ __forceinline__ u32x4 pack8(const float* f) { u32x4 w; w.x = cvtpk(f[0], f[1]); w.y = cvtpk(f[2], f[3]); w.z = cvtpk(f[4], f[5]); w.w = cvtpk(f[6], f[7]); return w; }

__device__ __forceinline__ int dn_row(int dir, int b, int s) {
  if (s < 256) { const int j = dir ? 255 - s : s; return 32768 + b * 256 + j; }
  int t = s - 256; if (dir) t = 16383 - t; return b * 16384 + t;
}
__device__ __forceinline__ bf16_t* uw_ptr(CP& p, int which, int dir, int b, int s) {
  if (s < 256) return (bf16_t*)(p.ws + (which ? O_WC : O_UC)) + ((size_t)((dir * 2 + b) * 256 + s)) * 1024;
  return (bf16_t*)p.out + ((size_t)((which * 2 + dir) * 2 + b) * 16384 + (size_t)(s - 256)) * 1024;
}

namespace gm {
constexpr int BM = 256, BK = 64, HALF = 128, HTB = HALF * BK * 2, NXCD = 8, WGM = 8;
__device__ __forceinline__ int lds_byte(int r, int c) { const int st = (r >> 4) * 2 + (c >> 5), rr = r & 15, cc = c & 31, ob = rr * 64 + cc * 2; return st * 1024 + (ob ^ (((ob >> 9) & 1) << 5)); }
__device__ __forceinline__ int perm32(int rho) { const int n = rho >> 4, i = rho & 15; return 8 * (i >> 2) + 4 * n + (i & 3); }
__device__ __forceinline__ void stage_rc(int b, int& R, int& C) { const int st = b / 1024, sb = b % 1024, swz = sb ^ (((sb >> 9) & 1) << 5); R = (st >> 1) * 16 + swz / 64; C = (st & 1) * 32 + (swz % 64) / 2; }
struct Unit { int pm, pn, seg; };
__device__ __forceinline__ bool tile_order(int i, int nM, int nN, int& pm, int& pn) {
  const int nwg = nM * nN; const long L = (long)i * gridDim.x + blockIdx.x; if (L >= nwg) return false;
  int wgid = (int)L; { const int q = nwg / NXCD, r = nwg % NXCD, xcd = wgid % NXCD, off = wgid / NXCD; wgid = (xcd < r ? xcd * (q + 1) : r * (q + 1) + (xcd - r) * q) + off; }
  const int nig = WGM * nN, gid = wgid / nig, fm = gid * WGM, gsz = (nM - fm) < WGM ? (nM - fm) : WGM;
  pm = fm + ((wgid % nig) % gsz); pn = (wgid % nig) / gsz; return true;
}

template <class Job>
__device__ __forceinline__ void gemm_phase(LAS unsigned char* lds, const Job& J, int wv_) {
  const int tid = TIDX, wid = __builtin_amdgcn_readfirstlane(tid >> 6), lane = tid & 63, wr = wid >> 2, wc = wid & 3, fr = lane & 15, fq = lane >> 4;
  const int K = J.K, nt = K / BK; const long lda = J.lda, ldb = J.ldb;
  unsigned voffA[2], voffB[2];
#pragma unroll
  for (int i = 0; i < 2; ++i) { int R, C; stage_rc(tid * 16 + i * 8192, R, C); const int Rb = (R & ~31) + perm32(R & 31); voffA[i] = (unsigned)(R * lda + C) * 2u; voffB[i] = (unsigned)(Rb * ldb + C) * 2u; }
  const size_t kstep = (size_t)(BK * 2);
  const size_t hstepA = (size_t)HALF * lda * 2, hstepB = (size_t)HALF * ldb * 2;
  const unsigned ldsw = (unsigned)wid * 1024u;
  const int aoff = lds_byte(wr * 64 + fr, fq * 8), boff = lds_byte(wc * 32 + fr, fq * 8);
#define G_SA(b, h) (((b) * 2 + (h)) * HTB)
#define G_SB(b, h) ((4 + (b) * 2 + (h)) * HTB)
#define G_STAGE(bufoff, gbase, voff) do { _Pragma("unroll") for (int _i = 0; _i < 2; ++_i) \
    __builtin_amdgcn_global_load_lds((const unsigned*)((const char*)(gbase) + (voff)[_i]), (LAS unsigned*)(lds + (bufoff) + ldsw + _i * 8192), 16, 0, 0); } while (0)
#define G_LDA(dst, b, h) do { _Pragma("unroll") for (int m = 0; m < 4; ++m) _Pragma("unroll") for (int k = 0; k < 2; ++k) dst[m][k] = *(const LAS bf16x8*)(lds + G_SA(b, h) + aoff + m * 2048 + k * 1024); } while (0)
#define G_LDB(dst, b, h) do { _Pragma("unroll") for (int n = 0; n < 2; ++n) _Pragma("unroll") for (int k = 0; k < 2; ++k) dst[n][k] = *(const LAS bf16x8*)(lds + G_SB(b, h) + boff + n * 2048 + k * 1024); } while (0)
#define G_MMA(ai, bj, At, Bt) do { __builtin_amdgcn_s_setprio(1); _Pragma("unroll") for (int m = 0; m < 4; ++m) _Pragma("unroll") for (int n = 0; n < 2; ++n) _Pragma("unroll") for (int k = 0; k < 2; ++k) \
    acc[ai][bj][m][n] = __builtin_amdgcn_mfma_f32_16x16x32_bf16(Bt[n][k], At[m][k], acc[ai][bj][m][n], 0, 0, 0); __builtin_amdgcn_s_setprio(0); } while (0)
#define G_WAIT_V(n) asm volatile("s_waitcnt vmcnt(" #n ")" ::: "memory")
#define G_WAIT_L(n) asm volatile("s_waitcnt lgkmcnt(" #n ")" ::: "memory")
#define G_BAR __builtin_amdgcn_s_barrier()
#define G_SCHED __builtin_amdgcn_sched_barrier(0)
#define G_ZERO() do { _Pragma("unroll") for (int a = 0; a < 2; ++a) _Pragma("unroll") for (int b = 0; b < 2; ++b) _Pragma("unroll") for (int m = 0; m < 4; ++m) _Pragma("unroll") for (int n = 0; n < 2; ++n) acc[a][b][m][n] = (f32x4){0.f, 0.f, 0.f, 0.f}; } while (0)
  Unit cur, nxt; int ui = 0;
  if (!J.next(0, cur)) return;
  f32x4 acc[2][2][4][2];
  G_ZERO();
  bf16x8 At[4][2], B0[2][2], B1[2][2];
  const char* cA = J.aptr(cur); const char* cB = J.bptr(cur);
  G_STAGE(G_SB(0, 0), cB, voffB); G_STAGE(G_SB(0, 1), cB + hstepB, voffB); G_STAGE(G_SA(0, 0), cA, voffA); G_STAGE(G_SA(0, 1), cA + hstepA, voffA);
  if (wr == 1) G_BAR;
  G_WAIT_V(2); G_BAR;
  G_STAGE(G_SB(1, 0), cB + kstep, voffB); G_STAGE(G_SA(1, 0), cA + kstep, voffA); G_STAGE(G_SB(1, 1), cB + hstepB + kstep, voffB);
  G_WAIT_V(6); G_BAR;
  for (;;) {
    const bool has_next = J.next(ui + 1, nxt);
    const char* nA = has_next ? J.aptr(nxt) : cA; const char* nB = has_next ? J.bptr(nxt) : cB;
    for (int t = 0; t < nt; t += 2) {
      const bool last = (t == nt - 2);
      const char* a1 = cA + (size_t)(t + 1) * kstep;
      const char* a2 = last ? nA : cA + (size_t)(t + 2) * kstep; const char* b2 = last ? nB : cB + (size_t)(t + 2) * kstep;
      const char* a3 = a2 + kstep; const char* b3 = b2 + kstep;
      G_LDB(B0, 0, 0); G_LDB(B1, 0, 1); G_SCHED; G_LDA(At, 0, 0); G_STAGE(G_SA(1, 1), a1 + hstepA, voffA);
      G_WAIT_V(8); G_WAIT_L(0); G_BAR; G_MMA(0, 0, At, B0); G_MMA(0, 1, At, B1); G_BAR; G_SCHED;
      G_LDA(At, 0, 1); G_STAGE(G_SB(0, 0), b2, voffB); G_STAGE(G_SB(0, 1), b2 + hstepB, voffB); G_STAGE(G_SA(0, 0), a2, voffA);
      G_WAIT_V(8); G_WAIT_L(0); G_BAR; G_MMA(1, 0, At, B0); G_MMA(1, 1, At, B1); G_BAR; G_SCHED;
      G_LDB(B0, 1, 0); G_LDB(B1, 1, 1); G_SCHED; G_LDA(At, 1, 0); G_STAGE(G_SA(0, 1), a2 + hstepA, voffA);
      G_WAIT_V(8); G_WAIT_L(0); G_BAR; G_MMA(0, 0, At, B0); G_MMA(0, 1, At, B1); G_BAR; G_SCHED;
      G_LDA(At, 1, 1); G_STAGE(G_SB(1, 0), b3, voffB); G_STAGE(G_SB(1, 1), b3 + hstepB, voffB); G_STAGE(G_SA(1, 0), a3, voffA);
      G_WAIT_V(8); G_WAIT_L(0); G_BAR; G_MMA(1, 0, At, B0); G_MMA(1, 1, At, B1); G_BAR; G_SCHED;
    }
    if (wr == 0) G_BAR;
    const bool z = J.epi(acc, cur, wr, wc, fr, fq);
    if (!has_next) break;
    if (z) G_ZERO();
    cur = nxt; cA = nA; cB = nB; ++ui;
    if (wr == 1) G_BAR;
  }
  G_WAIT_V(0);
  G_BAR;
#undef G_SA
#undef G_SB
#undef G_STAGE
#undef G_LDA
#undef G_LDB
#undef G_MMA
#undef G_ZERO
}

#define EPI_FOR(u) _Pragma("unroll") for (int ai = 0; ai < 2; ++ai) _Pragma("unroll") for (int m = 0; m < 4; ++m) _Pragma("unroll") for (int bj = 0; bj < 2; ++bj)
#define EPI_ROW(u) ((u).pm * 256 + ai * 128 + wr * 64 + m * 16 + fr)
#define EPI_COL(u) ((u).pn * 256 + bj * 128 + wc * 32 + fq * 8)
__device__ __forceinline__ void st_bf4(bf16_t* p, f32x4 v) { u32x2 w; w.x = cvtpk(v[0], v[1]); w.y = cvtpk(v[2], v[3]); *(u32x2*)p = w; }
__device__ __forceinline__ void st_bf8(bf16_t* p, f32x4 v0, f32x4 v1) { u32x4 w; w.x = cvtpk(v0[0], v0[1]); w.y = cvtpk(v0[2], v0[3]); w.z = cvtpk(v1[0], v1[1]); w.w = cvtpk(v1[2], v1[3]); *(u32x4*)p = w; }

struct JobBase {
  const char* A; const char* B; int K, lda, ldb, nM, nN;
  __device__ __forceinline__ bool next(int i, Unit& u) const {
    if (!tile_order(i, nM, nN, u.pm, u.pn)) return false;
    u.seg = 0; return true;
  }
  __device__ __forceinline__ const char* aptr(const Unit& u) const { return A + (size_t)u.pm * 256 * lda * 2; }
  __device__ __forceinline__ const char* bptr(const Unit& u) const { return B + (size_t)u.pn * 256 * ldb * 2; }
};
struct JobInproj : JobBase {
  char* ws;
  __device__ __forceinline__ bool epi(f32x4 (&acc)[2][2][4][2], const Unit& u, int wr, int wc, int fr, int fq) const {
    if (u.pn < 36) {
      bf16_t* base; int ldc, c0;
      if (u.pn < 4) { base = (bf16_t*)(ws + O_QKVA); ldc = 1024; c0 = u.pn * 256; }
      else if (u.pn < 16) { base = (bf16_t*)(ws + O_DQKV); ldc = 3072; c0 = (u.pn - 4) * 256; }
      else { base = (bf16_t*)(ws + O_ZG); ldc = 5120; c0 = (u.pn - 16) * 256; }
      EPI_FOR(u) { const int row = EPI_ROW(u), col = c0 + bj * 128 + wc * 32 + fq * 8; st_bf8(base + (size_t)row * ldc + col, acc[ai][bj][m][0], acc[ai][bj][m][1]); }
    } else {
      float* base = (float*)(ws + O_MISC);
      EPI_FOR(u) { const int row = EPI_ROW(u), col = bj * 128 + wc * 32 + fq * 8; if (col < 96) { *(f32x4*)(base + (size_t)row * 96 + col) = acc[ai][bj][m][0]; *(f32x4*)(base + (size_t)row * 96 + col + 4) = acc[ai][bj][m][1]; } }
    }
    return true;
  }
};
struct JobPlain : JobBase {
  bf16_t* O; int ldc;
  __device__ __forceinline__ bool epi(f32x4 (&acc)[2][2][4][2], const Unit& u, int wr, int wc, int fr, int fq) const {
    EPI_FOR(u) { const int row = EPI_ROW(u), col = EPI_COL(u); st_bf8(O + (size_t)row * ldc + col, acc[ai][bj][m][0], acc[ai][bj][m][1]); }
    return true;
  }
};
struct JobKV : JobBase {
  bf16_t* O; bf16_t* V; const float* rstd;
  __device__ __forceinline__ bool epi(f32x4 (&acc)[2][2][4][2], const Unit& u, int wr, int wc, int fr, int fq) const {
#pragma unroll
    for (int ai = 0; ai < 2; ++ai)
#pragma unroll
      for (int m = 0; m < 4; ++m) { const int row = u.pm * 256 + ai * 128 + wr * 64 + m * 16 + fr, c8 = wc * 32 + fq * 8;
        st_bf8(O + (size_t)row * 2048 + u.pn * 256 + c8, acc[ai][0][m][0], acc[ai][0][m][1]);
        int b, pos; if (row < 32768) { b = row >> 14; pos = row & 16383; } else { b = (row - 32768) >> 8; pos = 16384 + ((row - 32768) & 255); }
        const float rs = rstd[row * 2 + 1];
        st_bf8(V + ((size_t)(b * 8 + u.pn) * 16640 + pos) * 128 + c8, acc[ai][1][m][0] * rs, acc[ai][1][m][1] * rs); }
    return true;
  }
};
struct JobMerge : JobBase {
  const bf16_t* ZG; bf16_t* O;
  __device__ __forceinline__ bool next(int i, Unit& u) const {
    if (!tile_order(i >> 1, nM, nN, u.pm, u.pn)) return false;
    u.seg = i & 1; return true;
  }
  __device__ __forceinline__ const char* aptr(const Unit& u) const { return A + (size_t)u.pm * 256 * lda * 2 + (size_t)u.seg * 2048; }
  __device__ __forceinline__ const char* bptr(const Unit& u) const { return B + (size_t)u.pn * 256 * ldb * 2 + (size_t)u.seg * 2048; }
  __device__ __forceinline__ bool epi(f32x4 (&acc)[2][2][4][2], const Unit& u, int wr, int wc, int fr, int fq) const {
    if (u.seg == 0) {
      EPI_FOR(u) { const int row = EPI_ROW(u), col = EPI_COL(u); const bf16_t* z = ZG + (size_t)row * 5120 + col;
        float ga[8], gb[8]; unpack8(*(const u32x4*)(z + 1024), ga); unpack8(*(const u32x4*)(z + 3072), gb);
#pragma unroll
        for (int e = 0; e < 8; ++e) acc[ai][bj][m][e >> 2][e & 3] *= (1.f + __expf(-gb[e])) * __builtin_amdgcn_rcpf(1.f + __expf(-ga[e])); }
      return false;
    }
    EPI_FOR(u) { const int row = EPI_ROW(u), col = EPI_COL(u); const bf16_t* z = ZG + (size_t)row * 5120 + col;
      float gb[8]; unpack8(*(const u32x4*)(z + 3072), gb);
      f32x4 v0 = acc[ai][bj][m][0], v1 = acc[ai][bj][m][1];
#pragma unroll
      for (int e = 0; e < 4; ++e) { v0[e] *= sigmoid_f(gb[e]); v1[e] *= sigmoid_f(gb[4 + e]); }
      st_bf8(O + (size_t)row * 2048 + col, v0, v1); }
    return true;
  }
};
struct JobUpGlu : JobBase {
  bf16_t* O; const float* cw; float* side;
  __device__ __forceinline__ bool epi(f32x4 (&acc)[2][2][4][2], const Unit& u, int wr, int wc, int fr, int fq) const {
    const int c8 = u.pn * 128 + wc * 32 + fq * 8; const int lane = fq * 16 + fr;
    const int lp = (lane & 48) | ((fr + 15) & 15), ln = (lane & 48) | ((fr + 1) & 15);
    float w0[8], w1[8], w2[8];
    { const f32x4 a = *(const f32x4*)(cw + c8), b = *(const f32x4*)(cw + c8 + 4), c = *(const f32x4*)(cw + 5504 + c8), d = *(const f32x4*)(cw + 5504 + c8 + 4), e = *(const f32x4*)(cw + 11008 + c8), f = *(const f32x4*)(cw + 11008 + c8 + 4);
#pragma unroll
      for (int q = 0; q < 4; ++q) { w0[q] = a[q]; w0[4 + q] = b[q]; w1[q] = c[q]; w1[4 + q] = d[q]; w2[q] = e[q]; w2[4 + q] = f[q]; } }
#pragma unroll
    for (int ai = 0; ai < 2; ++ai) {
      const int rbase = u.pm * 256 + ai * 128 + wr * 64, rb = rbase >> 6;
      float ov[4][8];
#pragma unroll
      for (int s = 0; s < 8; ++s) {
        float g[4], rp[4], rn[4];
#pragma unroll
        for (int m = 0; m < 4; ++m) { g[m] = acc[ai][0][m][s >> 2][s & 3]; rp[m] = __shfl(g[m], lp); rn[m] = __shfl(g[m], ln); }
#pragma unroll
        for (int m = 0; m < 4; ++m) {
          const float pv = fr == 0 ? (m > 0 ? rp[m > 0 ? m - 1 : 0] : 0.f) : rp[m];
          const float nv = fr == 15 ? (m < 3 ? rn[m < 3 ? m + 1 : 3] : 0.f) : rn[m];
          const float cv = w0[s] * pv + w1[s] * g[m] + w2[s] * nv, vv = acc[ai][1][m][s >> 2][s & 3];
          ov[m][s] = silu_f(cv) * vv;
          if (m == 0 && fr == 0) { float* sp = side + ((size_t)(0 * 512 + rb) * 3) * 5504 + c8 + s; sp[0] = cv; sp[5504] = vv; sp[2 * 5504] = g[m]; }
          if (m == 3 && fr == 15) { float* sp = side + ((size_t)(1 * 512 + rb) * 3) * 5504 + c8 + s; sp[0] = cv; sp[5504] = vv; sp[2 * 5504] = g[m]; }
        }
      }
#pragma unroll
      for (int m = 0; m < 4; ++m) *(u32x4*)(O + (size_t)(rbase + m * 16 + fr) * 5504 + c8) = pack8(ov[m]);
    }
    return true;
  }
};
struct JobResid : JobBase {
  const float* base; const float* gate; float* out;
  __device__ __forceinline__ bool epi(f32x4 (&acc)[2][2][4][2], const Unit& u, int wr, int wc, int fr, int fq) const {
    EPI_FOR(u) { const int row = EPI_ROW(u), col = EPI_COL(u);
      const float* gp = gate + (size_t)(row >> 14) * 12288 + col; const float* xp = base + (size_t)row * 2048 + col; float* op = out + (size_t)row * 2048 + col;
      const f32x4 g0 = *(const f32x4*)gp, g1 = *(const f32x4*)(gp + 4), x0 = *(const f32x4*)xp, x1 = *(const f32x4*)(xp + 4);
      *(f32x4*)op = x0 + g0 * acc[ai][bj][m][0]; *(f32x4*)(op + 4) = x1 + g1 * acc[ai][bj][m][1]; }
    return true;
  }
};
}

__device__ __forceinline__ int win_srccol(int n) {
  if (n < 1024) return n; if (n < 5120) return n + 64; if (n < 9216) return n + 96;
  if (n < 9280) return 1024 + (n - 9216); if (n < 9296) return 5184 + (n - 9280); if (n < 9312) return 5200 + (n - 9296); return -1;
}
__device__ __forceinline__ void transpose_tile(int wv_, const float* __restrict__ src, int Nsrc, bf16_t* __restrict__ dst, int ldd, int k0, int n0, int mode, const float* __restrict__ kscale, float* tl) {
  const int tid = TIDX, nn = tid & 63;
  const int nd_ = n0 + nn;
  const int sc = mode == 1 ? win_srccol(nd_) : (mode == 2 ? ((nd_ >> 7) & 1) * 5504 + (nd_ >> 8) * 128 + (nd_ & 127) : nd_);
#pragma unroll
  for (int i = 0; i < 8; ++i) { const int kk = (tid >> 6) + 8 * i;
    float v = sc >= 0 ? src[(size_t)(k0 + kk) * Nsrc + sc] : 0.f;
    if (kscale) v *= kscale[k0 + kk];
    tl[kk * 65 + nn] = v; }
  __syncthreads();
  { const int n2 = tid >> 3, kc = tid & 7; float f[8];
#pragma unroll
    for (int j = 0; j < 8; ++j) f[j] = tl[(kc * 8 + j) * 65 + n2];
    *(u32x4*)(dst + (size_t)(n0 + n2) * ldd + k0 + kc * 8) = pack8(f); }
  __syncthreads();
}
__device__ __forceinline__ void phase_prep(CP& p, char* lds, int wv_, int it0 = 0) {
  float* tl = (float*)lds; const int tid = TIDX;
  constexpr int NADA = 384;
  constexpr int T1 = 32 * 148, T2 = T1 + 8 * 24, T3 = T2 + 8 * 32, T4 = T3 + 16 * 32, T5 = T4 + 16 * 32, T6 = T5 + 32 * 32, T7 = T6 + 32 * 172, T8 = T7 + 86 * 32;
  for (int it = it0 + blockIdx.x; it < NADA + T8; it += gridDim.x) {
    if (it < NADA) {
      const int cgp = it % 6, kc = it / 6, col = cgp * 2048 + tid * 4;
      if (tid < 96) { const int r = tid >> 5, k = kc * 32 + (tid & 31); const float cv = r < 2 ? p.in[I_C][r * 2048 + k] : p.in[I_CCTX][k]; tl[tid] = silu_f(cv); }
      __syncthreads();
      f32x4 a0 = {0, 0, 0, 0}, a1 = a0, a2 = a0;
      const float* w = p.in[I_WADA] + (size_t)(kc * 32) * 12288 + col;
#pragma unroll 8
      for (int k = 0; k < 32; ++k) { const f32x4 wv = *(const f32x4*)(w + (size_t)k * 12288); a0 += tl[k] * wv; a1 += tl[32 + k] * wv; a2 += tl[64 + k] * wv; }
      if (kc == 0) { const f32x4 bv = *(const f32x4*)(p.in[I_BADA] + col); a0 += bv; a1 += bv; a2 += bv; }
      float* mod = (float*)(p.ws + O_MOD);
#pragma unroll
      for (int e = 0; e < 4; ++e) { atomicAdd(mod + col + e, a0[e]); atomicAdd(mod + 12288 + col + e, a1[e]); atomicAdd(mod + 2 * 12288 + col + e, a2[e]); }
      __syncthreads();
    } else {
      int t = it - NADA;
      if (t < T1) { transpose_tile(wv_, p.in[I_WIN], 9312, (bf16_t*)(p.ws + O_WIN), 2048, (t % 32) * 64, (t / 32) * 64, 1, nullptr, tl); }
      else if (t < T2) { t -= T1; transpose_tile(wv_, p.in[I_WQB], 1536, (bf16_t*)(p.ws + O_WQB), 512, (t % 8) * 64, (t / 8) * 64, 0, p.in[I_QAN], tl); }
      else if (t < T3) { t -= T2; transpose_tile(wv_, p.in[I_WKVB], 2048, (bf16_t*)(p.ws + O_WKVB), 512, (t % 8) * 64, (t / 8) * 64, 0, p.in[I_KVAN], tl); }
      else if (t < T4) { t -= T3; transpose_tile(wv_, p.in[I_WOMLA], 2048, (bf16_t*)(p.ws + O_WCAT), 2048, (t % 16) * 64, (t / 16) * 64, 0, nullptr, tl); }
      else if (t < T5) { t -= T4; transpose_tile(wv_, p.in[I_WODN], 2048, (bf16_t*)(p.ws + O_WCAT) + 1024, 2048, (t % 16) * 64, (t / 16) * 64, 0, nullptr, tl); }
      else if (t < T6) { t -= T5; transpose_tile(wv_, p.in[I_WOUT], 2048, (bf16_t*)(p.ws + O_WOUT), 2048, (t % 32) * 64, (t / 32) * 64, 0, nullptr, tl); }
      else if (t < T7) { t -= T6; transpose_tile(wv_, p.in[I_WUP], 11008, (bf16_t*)(p.ws + O_WUP), 2048, (t % 32) * 64, (t / 32) * 64, 2, nullptr, tl); }
      else { t -= T7; transpose_tile(wv_, p.in[I_WDOWN], 2048, (bf16_t*)(p.ws + O_WDN), 5504, (t % 86) * 64, (t / 86) * 64, 0, nullptr, tl); }
    }
  }
}

template <int which> __device__ __forceinline__ void phase_normmod(CP& p, int wv_) {
  const int tid = TIDX, lane = tid & 63, gw = blockIdx.x * 8 + (tid >> 6), nw = gridDim.x * 8;
  const float* mod = (const float*)(p.ws + O_MOD);
  const int nrows = which ? 32768 : 33280;
  const float* wn = p.in[which ? I_NFFN : I_NMIX];
  bf16_t* dst = (bf16_t*)(p.ws + (which ? O_XN2 : O_XN));
  auto rowsrc = [&](int r) -> const float* {
    if (which) return p.out + (size_t)r * 2048;
    return r < 32768 ? p.in[I_X] + (size_t)r * 2048 : p.in[I_CTX] + (size_t)(r - 32768) * 2048; };
  f32x4 v[8];
  if (gw < nrows) { const float* src = rowsrc(gw);
#pragma unroll
    for (int j = 0; j < 8; ++j) v[j] = *(const f32x4*)(src + (j * 64 + lane) * 4); }
  for (int r = gw; r < nrows; r += nw) {
    f32x4 vn[8];
    { const float* src = rowsrc(min(r + nw, nrows - 1));
#pragma unroll
      for (int j = 0; j < 8; ++j) vn[j] = *(const f32x4*)(src + (j * 64 + lane) * 4); }
    const int mr = which ? (r >> 14) : (r < 32768 ? (r >> 14) : 2);
    const float* sh = mod + mr * 12288 + (which ? 3 : 0) * 2048; const float* sc = sh + 2048;
    float ss = 0.f;
#pragma unroll
    for (int j = 0; j < 8; ++j) ss += v[j][0] * v[j][0] + v[j][1] * v[j][1] + v[j][2] * v[j][2] + v[j][3] * v[j][3];
#pragma unroll
    for (int o = 1; o < 64; o <<= 1) ss += __shfl_xor(ss, o);
    const float rstd = rsqrtf(ss * (1.f / 2048.f) + EPS);
#pragma unroll
    for (int j = 0; j < 8; ++j) { const int c = (j * 64 + lane) * 4;
      const f32x4 w4 = *(const f32x4*)(wn + c), s4 = *(const f32x4*)(sc + c), h4 = *(const f32x4*)(sh + c);
      f32x4 y;
#pragma unroll
      for (int e = 0; e < 4; ++e) y[e] = (v[j][e] * rstd * w4[e]) * (1.f + s4[e]) + h4[e];
      gm::st_bf4(dst + (size_t)r * 2048 + c, y); }
#pragma unroll
    for (int j = 0; j < 8; ++j) v[j] = vn[j];
  }
}

__device__ __forceinline__ void phase_dnprep(CP& p, int wv_) {
  const int tid = TIDX, lane = tid & 63, gw = blockIdx.x * 8 + (tid >> 6), nw = gridDim.x * 8;
  const bf16_t* DQKV = (const bf16_t*)(p.ws + O_DQKV);
  {
    const int type = gw % 3, wsub = gw / 3, nsub = (nw - type + 2) / 3, c0 = lane * 16;
    float w0[16], w1[16], w2[16];
    { const float* cw = p.in[I_DNCONV] + type * 1024 + c0;
#pragma unroll
      for (int e = 0; e < 16; ++e) { w0[e] = cw[e]; w1[e] = cw[3072 + e]; w2[e] = cw[2 * 3072 + e]; } }
    bf16_t* dbase = (bf16_t*)(p.ws + (type == 0 ? O_QN : (type == 1 ? O_KN : O_VN))) + c0;
    const int nrows = type == 0 ? 32768 : 33280;
    for (int r0 = wsub; r0 < nrows; r0 += 4 * nsub) {
      u32x4 ld[4][6]; float mp[4], mn[4];
#pragma unroll
      for (int u = 0; u < 4; ++u) { const int r = min(r0 + u * nsub, nrows - 1); int pos, len;
        if (r < 32768) { pos = r & 16383; len = 16384; } else { pos = (r - 32768) & 255; len = 256; }
        mp[u] = pos > 0 ? 1.f : 0.f; mn[u] = pos < len - 1 ? 1.f : 0.f;
        const bf16_t* row = DQKV + (size_t)r * 3072 + type * 1024 + c0; const bf16_t* rp = pos > 0 ? row - 3072 : row; const bf16_t* rn = pos < len - 1 ? row + 3072 : row;
        ld[u][0] = *(const u32x4*)row; ld[u][1] = *(const u32x4*)(row + 8); ld[u][2] = *(const u32x4*)rp; ld[u][3] = *(const u32x4*)(rp + 8); ld[u][4] = *(const u32x4*)rn; ld[u][5] = *(const u32x4*)(rn + 8); }
#pragma unroll
      for (int u = 0; u < 4; ++u) { const int r = r0 + u * nsub; if (r >= nrows) break;
        float a[16], x[16];
        unpack8(ld[u][0], x); unpack8(ld[u][1], x + 8);
#pragma unroll
        for (int e = 0; e < 16; ++e) a[e] = w1[e] * x[e];
        unpack8(ld[u][2], x); unpack8(ld[u][3], x + 8);
#pragma unroll
        for (int e = 0; e < 16; ++e) a[e] += mp[u] * w0[e] * x[e];
        unpack8(ld[u][4], x); unpack8(ld[u][5], x + 8);
#pragma unroll
        for (int e = 0; e < 16; ++e) a[e] += mn[u] * w2[e] * x[e];
        float ss = 0.f;
#pragma unroll
        for (int e = 0; e < 16; ++e) { a[e] = silu_f(a[e]); ss += a[e] * a[e]; }
        if (type < 2) { ss += __shfl_xor(ss, 1); ss += __shfl_xor(ss, 2); ss += __shfl_xor(ss, 4);
          float sc = rsqrtf(ss + EPS); if (type == 0) sc *= 0.08838834764831845f;
#pragma unroll
          for (int e = 0; e < 16; ++e) a[e] *= sc; }
        bf16_t* dst = dbase + (size_t)r * 1024;
        *(u32x4*)dst = pack8(a); *(u32x4*)(dst + 8) = pack8(a + 8); }
    }
  }
  for (int r = gw; r < 33280; r += nw) {
    int b, pos; const bool isctx = r >= 32768;
    if (!isctx) { b = r >> 14; pos = r & 16383; } else { b = (r - 32768) >> 8; pos = (r - 32768) & 255; }
    const bf16_t* row = (const bf16_t*)(p.ws + O_QKVA) + (size_t)r * 1024 + lane * 16;
    float x[16]; { u32x4 q0 = *(const u32x4*)row, q1 = *(const u32x4*)(row + 8); unpack8(q0, x); unpack8(q1, x + 8); }
    float ss = 0.f;
#pragma unroll
    for (int e = 0; e < 16; ++e) ss += x[e] * x[e];
#pragma unroll
    for (int o = 1; o < 32; o <<= 1) ss += __shfl_xor(ss, o);
    if ((lane & 31) == 0) ((float*)(p.ws + O_RSTD))[r * 2 + (lane >> 5)] = rsqrtf(ss * (1.f / 512.f) + EPS);
    if (lane < 16) { const int dir = lane >> 3, h = lane & 7;
      const float* mi = (const float*)(p.ws + O_MISC) + (size_t)r * 96;
      const float da = mi[64 + lane] + p.in[I_DTB][lane], db = mi[80 + lane];
      const float sp = fmaxf(da, 0.f) + log1pf(__expf(-fabsf(da)));
      const float g = -__expf(p.in[I_ALOG][lane]) * sp;
      const int s_ = isctx ? (dir ? 255 - pos : pos) : 256 + (dir ? 16383 - pos : pos);
      const size_t o = (size_t)((dir * 2 + b) * 8 + h) * 16640 + s_;
      ((float*)(p.ws + O_G))[o] = g; ((float*)(p.ws + O_BETA))[o] = sigmoid_f(db); }
  }
}

__device__ __forceinline__ void phase_chunk(CP& p, char* lds, int wv_) {
  const int tid = TIDX, half = tid >> 8, t256 = tid & 255, w4 = (tid >> 6) & 3, lane = tid & 63, fr = lane & 15, fq = lane >> 4;
  char* hb = lds + half * 70400;
  bf16_t* kL = (bf16_t*)hb; bf16_t* qL = (bf16_t*)(hb + 17408); bf16_t* vL = (bf16_t*)(hb + 34816); float* Mm = (float*)(hb + 52224); float* gcL = (float*)(hb + 69632); float* beL = gcL + 64; float* bwL = gcL + 128;
  const bf16_t* QN = (const bf16_t*)(p.ws + O_QN); const bf16_t* KN = (const bf16_t*)(p.ws + O_KN); const bf16_t* VN = (const bf16_t*)(p.ws + O_VN);
  u32x4 pk_[4], pq_[4], pv_[4]; float pg_ = 0.f, pb_ = 0.f;
#define CH_LOAD(prx) do { const int idx_ = (prx) * 2 + half, c_ = idx_ % 260, grp_ = idx_ / 260, h_ = grp_ & 7, b_ = (grp_ >> 3) & 1, dir_ = grp_ >> 4, s0_ = c_ * 64; \
    _Pragma("unroll") for (int i = 0; i < 4; ++i) { const int id = t256 + 256 * i, rr = id >> 4, c8 = (id & 15) * 8; const size_t row = dn_row(dir_, b_, s0_ + rr); \
      pk_[i] = *(const u32x4*)(KN + row * 1024 + h_ * 128 + c8); pq_[i] = *(const u32x4*)(QN + row * 1024 + h_ * 128 + c8); pv_[i] = *(const u32x4*)(VN + row * 1024 + h_ * 128 + c8); } \
    if (t256 < 64) { const size_t go_ = (size_t)grp_ * 16640 + s0_; pg_ = ((const float*)(p.ws + O_G))[go_ + t256]; pb_ = ((const float*)(p.ws + O_BETA))[go_ + t256]; } } while (0)
  if ((int)blockIdx.x < 4160) CH_LOAD(blockIdx.x);
  for (int pr = blockIdx.x; pr < 4160; pr += gridDim.x) {
    const int idx = pr * 2 + half, c = idx % 260, grp = idx / 260, h = grp & 7, b = (grp >> 3) & 1, dir = grp >> 4, s0 = c * 64;
    const size_t go = (size_t)grp * 16640 + s0;
#pragma unroll
    for (int i = 0; i < 4; ++i) { const int id = t256 + 256 * i, rr = id >> 4, c8 = (id & 15) * 8;
      *(u32x4*)(kL + rr * 136 + c8) = pk_[i]; *(u32x4*)(qL + rr * 136 + c8) = pq_[i]; *(u32x4*)(vL + rr * 136 + c8) = pv_[i]; }
    if (t256 < 64) { float g = pg_;
#pragma unroll
      for (int o = 1; o < 64; o <<= 1) { const float n = __shfl_up(g, o); if (t256 >= o) g += n; }
      const float be_ = pb_; gcL[t256] = g; beL[t256] = be_; bwL[t256] = be_ * __expf(g); ((float*)(p.ws + O_GC))[go + t256] = g; }
    if (pr + (int)gridDim.x < 4160) CH_LOAD(pr + gridDim.x);
    __syncthreads();
    {
      bf16x8 ak[4], aq[4];
#pragma unroll
      for (int kk = 0; kk < 4; ++kk) { ak[kk] = *(const bf16x8*)(kL + (w4 * 16 + fr) * 136 + kk * 32 + fq * 8); aq[kk] = *(const bf16x8*)(qL + (w4 * 16 + fr) * 136 + kk * 32 + fq * 8); }
      bf16_t* Ag = (bf16_t*)(p.ws + O_ACH) + (size_t)idx * 4096;
#pragma unroll
      for (int jb = 0; jb < 4; ++jb) {
        f32x4 dk = {0, 0, 0, 0}, dq = {0, 0, 0, 0};
#pragma unroll
        for (int kk = 0; kk < 4; ++kk) { const bf16x8 bb = *(const bf16x8*)(kL + (jb * 16 + fr) * 136 + kk * 32 + fq * 8);
          dk = __builtin_amdgcn_mfma_f32_16x16x32_bf16(ak[kk], bb, dk, 0, 0, 0); dq = __builtin_amdgcn_mfma_f32_16x16x32_bf16(aq[kk], bb, dq, 0, 0, 0); }
        const int j = jb * 16 + fr; const float gj = gcL[j];
#pragma unroll
        for (int jj = 0; jj < 4; ++jj) { const int i = w4 * 16 + fq * 4 + jj; const float e = __expf(gcL[i] - gj);
          Mm[i * 68 + j] = (j < i) ? beL[i] * dk[jj] * e : 0.f;
          if (c >= 4) Ag[i * 64 + j] = f2bf((j <= i) ? dq[jj] * e : 0.f); }
      }
    }
    __syncthreads();
    {
      const int cc = t256 & 127; const bool isw = t256 >= 128;
      bf16_t* colp = (isw ? kL : vL) + cc; const float* fL = isw ? bwL : beL;
      f32v2_t xp[32];
#pragma unroll
      for (int i = 0; i < 64; ++i) {
        f32v2_t ra = {bf2f(colp[i * 136]) * fL[i], 0.f}, rb = {0.f, 0.f};
#pragma unroll
        for (int q = 0; q < i / 2; ++q) { const f32v2_t mp = *(const f32v2_t*)(Mm + i * 68 + 2 * q); if (q & 1) rb -= mp * xp[q]; else ra -= mp * xp[q]; }
        float r = (ra.x + ra.y) + (rb.x + rb.y);
        if (i & 1) r -= Mm[i * 68 + i - 1] * xp[i / 2].x;
        if (i & 1) xp[i / 2].y = r; else xp[i / 2].x = r;
        colp[i * 136] = f2bf(r);
        if ((i & 3) == 3) __builtin_amdgcn_sched_barrier(0);
      }
    }
    __syncthreads();
    { bf16_t* ub = uw_ptr(p, 0, dir, b, s0) + h * 128; bf16_t* wb = uw_ptr(p, 1, dir, b, s0) + h * 128;
#pragma unroll
      for (int i = 0; i < 4; ++i) { const int id = t256 + 256 * i, rr = id >> 4, c8 = (id & 15) * 8;
        *(u32x4*)(ub + (size_t)rr * 1024 + c8) = *(const u32x4*)(vL + rr * 136 + c8);
        *(u32x4*)(wb + (size_t)rr * 1024 + c8) = *(const u32x4*)(kL + rr * 136 + c8); } }
    __syncthreads();
  }
}

__device__ __forceinline__ void phase_scan(CP& p, char* lds, int wv_) {
  const int tid = TIDX, wid = tid >> 6, lane = tid & 63, fr = lane & 15, fq = lane >> 4;
  constexpr int WL = 0, QL = 17408, KT = 34816, AL = 53248, BUFSZ = 62464;
  bf16_t* ST = (bf16_t*)(lds + 2 * BUFSZ); bf16_t* VT = (bf16_t*)(lds + 2 * BUFSZ + 4352); bf16_t* VT2 = (bf16_t*)(lds + 2 * BUFSZ + 4352 + 2304);
  const int r0 = tid >> 4, c8 = (tid & 15) * 8, arow = tid >> 3, ac8 = (tid & 7) * 8;
  for (int item = blockIdx.x; item < 256; item += gridDim.x) {
    const int slice = item >> 5, grp = item & 31, h = grp & 7, b = (grp >> 3) & 1, dir = grp >> 4;
    const float* GCp = (const float*)(p.ws + O_GC) + (size_t)grp * 16640;
    const bf16_t* ACHp = (const bf16_t*)(p.ws + O_ACH) + (size_t)grp * 260 * 4096 + arow * 64 + ac8;
    const bf16_t* Wc = uw_ptr(p, 1, dir, b, 0); const bf16_t* Wl = uw_ptr(p, 1, dir, b, 256); const bf16_t* Uc = uw_ptr(p, 0, dir, b, 0); const bf16_t* Ul = uw_ptr(p, 0, dir, b, 256);
    const bf16_t* QNb = (const bf16_t*)(p.ws + O_QN); const bf16_t* KNb = (const bf16_t*)(p.ws + O_KN);
    const int woff = r0 * 1024 + h * 128 + c8;
    const int qkoff = (dir ? -r0 : r0) * 1024 + h * 128 + c8, qkstep = dir ? -32768 : 32768;
    const int uoff = ((wid & 3) * 16 + fq * 4) * 1024 + h * 128 + slice * 16 + fr;
    const int goff = (wid & 3) * 16 + fq * 4;
    u32x4 lw0, lw1, lq0, lq1, lk0, lk1, la0; f32x4 lg; float gl_r, gend_cur; float fac[4];
    bf16_t un[4] = {0, 0, 0, 0}; float uc[4];
#define SC_LOAD(c) do { const int c_ = (c); const bool ctx_ = c_ < 4; const int cc_ = ctx_ ? c_ : c_ - 4; \
      const bf16_t* wb_ = (ctx_ ? Wc : Wl) + (size_t)cc_ * 65536; const bf16_t* ub_ = (ctx_ ? Uc : Ul) + (size_t)cc_ * 65536; \
      const long row_ = ctx_ ? (32768 + b * 256 + (dir ? 255 - cc_ * 64 : cc_ * 64)) : (b * 16384 + (dir ? 16383 - cc_ * 64 : cc_ * 64)); \
      const bf16_t* qb_ = QNb + row_ * 1024; const bf16_t* kb_ = KNb + row_ * 1024; \
      lw0 = *(const u32x4*)(wb_ + woff); lw1 = *(const u32x4*)(wb_ + woff + 32768); \
      lq0 = *(const u32x4*)(qb_ + qkoff); lq1 = *(const u32x4*)(qb_ + qkoff + qkstep); \
      lk0 = *(const u32x4*)(kb_ + qkoff); lk1 = *(const u32x4*)(kb_ + qkoff + qkstep); \
      la0 = *(const u32x4*)(ACHp + (size_t)c_ * 4096); \
      gl_r = GCp[c_ * 64 + 63]; lg = *(const f32x4*)(GCp + c_ * 64 + goff); \
      if (wid < 4) { _Pragma("unroll") for (int jj = 0; jj < 4; ++jj) un[jj] = ub_[uoff + jj * 1024]; } } while (0)
#define SC_WRITE(bufp) do { char* bp_ = (bufp); float f_[8]; \
      *(u32x4*)(bp_ + WL + (r0 * 136 + c8) * 2) = lw0; *(u32x4*)(bp_ + WL + ((r0 + 32) * 136 + c8) * 2) = lw1; \
      *(u32x4*)(bp_ + QL + (r0 * 136 + c8) * 2) = lq0; *(u32x4*)(bp_ + QL + ((r0 + 32) * 136 + c8) * 2) = lq1; \
      unpack8(lk0, f_); _Pragma("unroll") for (int e = 0; e < 8; ++e) *(bf16_t*)(bp_ + KT + ((c8 + e) * 72 + ((r0 + c8) & 63)) * 2) = f2bf(f_[e]); \
      unpack8(lk1, f_); _Pragma("unroll") for (int e = 0; e < 8; ++e) *(bf16_t*)(bp_ + KT + ((c8 + e) * 72 + ((r0 + 32 + c8) & 63)) * 2) = f2bf(f_[e]); \
      *(u32x4*)(bp_ + AL + (arow * 72 + ac8) * 2) = la0; gend_cur = __expf(gl_r); \
      _Pragma("unroll") for (int jj = 0; jj < 4; ++jj) { uc[jj] = bf2f(un[jj]); fac[jj] = wid < 4 ? __expf(gl_r - lg[jj]) : __expf(lg[jj]); } } while (0)
    f32x4 S = {0, 0, 0, 0};
    for (int i = tid; i < 16 * 136 / 2; i += 512) ((unsigned*)ST)[i] = 0u;
    SC_LOAD(0); SC_WRITE(lds);
    SC_LOAD(1);
    __syncthreads();
    for (int c = 0; c < 260; ++c) {
      char* buf = lds + (c & 1) * BUFSZ;
      f32x4 acc = {0, 0, 0, 0};
      { const int ib = wid & 3; const char* ab = buf + (wid < 4 ? WL : QL);
        f32x4 acc1 = {0, 0, 0, 0};
#pragma unroll
        for (int kk = 0; kk < 4; ++kk) { const bf16x8 a = *(const bf16x8*)(ab + ((ib * 16 + fr) * 136 + kk * 32 + fq * 8) * 2); const bf16x8 bb = *(const bf16x8*)(ST + fr * 136 + kk * 32 + fq * 8);
          if (kk & 1) acc1 = __builtin_amdgcn_mfma_f32_16x16x32_bf16(a, bb, acc1, 0, 0, 0); else acc = __builtin_amdgcn_mfma_f32_16x16x32_bf16(a, bb, acc, 0, 0, 0); }
        acc += acc1;
        if (wid < 4) { float vn_[4];
#pragma unroll
          for (int jj = 0; jj < 4; ++jj) vn_[jj] = uc[jj] - acc[jj];
          u32x2 w; w.x = cvtpk(vn_[0], vn_[1]); w.y = cvtpk(vn_[2], vn_[3]); *(u32x2*)(VT + fr * 72 + ib * 16 + fq * 4) = w;
          w.x = cvtpk(vn_[0] * fac[0], vn_[1] * fac[1]); w.y = cvtpk(vn_[2] * fac[2], vn_[3] * fac[3]); *(u32x2*)(VT2 + fr * 72 + ib * 16 + fq * 4) = w; }
        else {
#pragma unroll
          for (int jj = 0; jj < 4; ++jj) acc[jj] *= fac[jj]; } }
      __syncthreads();
      { f32x4 sa = S * gend_cur, sb = {0, 0, 0, 0};
#pragma unroll
        for (int kk = 0; kk < 2; ++kk) { const bf16x8 a = *(const bf16x8*)(buf + KT + ((wid * 16 + fr) * 72 + ((kk * 32 + fq * 8 + ((wid * 16 + fr) & ~7)) & 63)) * 2); const bf16x8 bb = *(const bf16x8*)(VT2 + fr * 72 + kk * 32 + fq * 8);
          if (kk) sb = __builtin_amdgcn_mfma_f32_16x16x32_bf16(a, bb, sb, 0, 0, 0); else sa = __builtin_amdgcn_mfma_f32_16x16x32_bf16(a, bb, sa, 0, 0, 0); }
        sa += sb;
        S = sa; u32x2 w; w.x = cvtpk(S[0], S[1]); w.y = cvtpk(S[2], S[3]); *(u32x2*)(ST + fr * 136 + wid * 16 + fq * 4) = w; }
      if (wid >= 4) { const int ib = wid - 4;
#pragma unroll
        for (int kk = 0; kk < 2; ++kk) { const bf16x8 a = *(const bf16x8*)(buf + AL + ((ib * 16 + fr) * 72 + kk * 32 + fq * 8) * 2); const bf16x8 bb = *(const bf16x8*)(VT + fr * 72 + kk * 32 + fq * 8);
          acc = __builtin_amdgcn_mfma_f32_16x16x32_bf16(a, bb, acc, 0, 0, 0); }
        if (c >= 4) { bf16_t* ob_ = (bf16_t*)(p.ws + O_OSC) + ((size_t)(dir * 2 + b) * 16384 + (size_t)(c * 64 + ib * 16 + fq * 4 - 256)) * 1024 + h * 128 + slice * 16 + fr;
#pragma unroll
          for (int jj = 0; jj < 4; ++jj) ob_[jj * 1024] = f2bf(acc[jj]); } }
      if (c + 1 < 260) { SC_WRITE(lds + ((c + 1) & 1) * BUFSZ); }
      if (c + 2 < 260) SC_LOAD(c + 2);
      __syncthreads();
    }
#undef SC_LOAD
#undef SC_WRITE
  }
}

__device__ __forceinline__ float rope_apply(float y, int lane, int t) {
  const int i = lane & 15; const int pos = (lane < 32) ? (t >> 6) : (t & 63);
  const float inv = exp2f(-(float)i * (13.287712379549449f / 16.f));
  const float ang = (float)pos * inv; const float cs = __cosf(ang), sn = __sinf(ang);
  const float o = __shfl_xor(y, 16);
  return (lane & 16) ? (y * cs + o * sn) : (y * cs - o * sn);
}
__device__ __forceinline__ void phase_mlafin(CP& p, int wv_) {
  const int tid = TIDX, lane = tid & 63, gw = blockIdx.x * 8 + (tid >> 6), nw = gridDim.x * 8;
  const float* RSTD = (const float*)(p.ws + O_RSTD);
  constexpr int NQ = 32768 * 8, NK = 33280 * 8, NY = 32768, UB = 8;
  { const float* qn = p.in[I_QN]; const float n0 = qn[lane], n1 = qn[lane + 64], n2 = qn[lane + 128];
    for (int it0 = gw; it0 < NQ; it0 += UB * nw) {
      float y0[UB], y1[UB], y2[UB], rs[UB];
#pragma unroll
      for (int u = 0; u < UB; ++u) { const int it = min(it0 + u * nw, NQ - 1), row = it >> 3, h = it & 7;
        const bf16_t* src = (const bf16_t*)p.out + (size_t)row * 1536 + h * 192;
        y0[u] = bf2f(src[lane]); y1[u] = bf2f(src[lane + 64]); y2[u] = bf2f(src[lane + 128]); rs[u] = RSTD[row * 2]; }
#pragma unroll
      for (int u = 0; u < UB; ++u) { const int it = it0 + u * nw; if (it >= NQ) break; const int row = it >> 3, h = it & 7, b = row >> 14, t = row & 16383;
        float a0 = y0[u] * rs[u], a1 = y1[u] * rs[u], a2 = y2[u] * rs[u];
        float ss = a0 * a0 + a1 * a1 + a2 * a2;
#pragma unroll
        for (int o = 1; o < 64; o <<= 1) ss += __shfl_xor(ss, o);
        const float r = rsqrtf(ss * (1.f / 192.f) + EPS);
        a0 *= r * n0; a1 *= r * n1; a2 *= r * n2;
        a2 = rope_apply(a2, lane, t);
        bf16_t* dst = (bf16_t*)(p.ws + O_Q) + ((size_t)(b * 8 + h) * 16384 + t) * 192;
        dst[lane] = f2bf(a0); dst[lane + 64] = f2bf(a1); dst[lane + 128] = f2bf(a2); }
    } }
  { const float* kn = p.in[I_KNORM]; const float n0 = kn[lane], n1 = kn[lane + 64], n2 = kn[lane + 128];
    for (int it0 = gw; it0 < NK; it0 += UB * nw) {
      float y0[UB], y1[UB], y2[UB], rs[UB];
#pragma unroll
      for (int u = 0; u < UB; ++u) { const int it = min(it0 + u * nw, NK - 1), row = it >> 3, h = it & 7;
        const bf16_t* src = (const bf16_t*)(p.ws + O_KVRAW) + (size_t)row * 2048 + h * 256;
        y0[u] = bf2f(src[lane]); y1[u] = bf2f(src[lane + 64]);
        y2[u] = ((const float*)(p.ws + O_MISC))[(size_t)row * 96 + lane]; rs[u] = RSTD[row * 2 + 1]; }
#pragma unroll
      for (int u = 0; u < UB; ++u) { const int it = it0 + u * nw; if (it >= NK) break; const int row = it >> 3, h = it & 7; int b, pos, t = 0; const bool lat = row < 32768;
        if (lat) { b = row >> 14; t = row & 16383; pos = t; } else { b = (row - 32768) >> 8; pos = 16384 + ((row - 32768) & 255); }
        float a0 = y0[u] * rs[u], a1 = y1[u] * rs[u], a2 = y2[u];
        float ss = a0 * a0 + a1 * a1 + a2 * a2;
#pragma unroll
        for (int o = 1; o < 64; o <<= 1) ss += __shfl_xor(ss, o);
        const float r = rsqrtf(ss * (1.f / 192.f) + EPS);
        a0 *= r * n0; a1 *= r * n1; a2 *= r * n2;
        const float a2r = rope_apply(a2, lane, t); if (lat) a2 = a2r;
        bf16_t* dk = (bf16_t*)(p.ws + O_K) + ((size_t)(b * 8 + h) * 16640 + pos) * 192;
        dk[lane] = f2bf(a0); dk[lane + 64] = f2bf(a1); dk[lane + 128] = f2bf(a2);
        }
    } }
  { const int c0 = lane * 16; float on[16];
#pragma unroll
    for (int e = 0; e < 16; ++e) on[e] = p.in[I_ONORM][(c0 & 127) + e];
    for (int it0 = gw; it0 < NY; it0 += 2 * nw) {
      u32x4 wa[2][2], wb[2][2], wz[2][2];
#pragma unroll
      for (int u = 0; u < 2; ++u) { const int row = min(it0 + u * nw, NY - 1), b = row >> 14, t = row & 16383;
        const bf16_t* of = (const bf16_t*)(p.ws + O_OSC) + ((size_t)(0 * 2 + b) * 16384 + t) * 1024 + c0;
        const bf16_t* ob = (const bf16_t*)(p.ws + O_OSC) + ((size_t)(1 * 2 + b) * 16384 + (16383 - t)) * 1024 + c0;
        const bf16_t* zz = (const bf16_t*)(p.ws + O_ZG) + (size_t)row * 5120 + c0;
        wa[u][0] = *(const u32x4*)of; wa[u][1] = *(const u32x4*)(of + 8); wb[u][0] = *(const u32x4*)ob; wb[u][1] = *(const u32x4*)(ob + 8); wz[u][0] = *(const u32x4*)zz; wz[u][1] = *(const u32x4*)(zz + 8); }
#pragma unroll
      for (int u = 0; u < 2; ++u) { const int row = it0 + u * nw; if (row >= NY) break;
        float a[16], x[16], z[16];
        unpack8(wa[u][0], a); unpack8(wa[u][1], a + 8); unpack8(wb[u][0], x); unpack8(wb[u][1], x + 8); unpack8(wz[u][0], z); unpack8(wz[u][1], z + 8);
        float ss = 0.f;
#pragma unroll
        for (int e = 0; e < 16; ++e) { a[e] += x[e]; ss += a[e] * a[e]; }
        ss += __shfl_xor(ss, 1); ss += __shfl_xor(ss, 2); ss += __shfl_xor(ss, 4);
        const float r = rsqrtf(ss * (1.f / 128.f) + EPS);
#pragma unroll
        for (int e = 0; e < 16; ++e) a[e] = a[e] * r * on[e] * silu_f(z[e]);
        bf16_t* dst = (bf16_t*)((char*)p.out + DO_YCAT) + (size_t)row * 2048 + 1024 + c0;
        *(u32x4*)dst = pack8(a); *(u32x4*)(dst + 8) = pack8(a + 8); }
    } }
}

namespace att {
constexpr int NW = 8, QBLK = 32, KVBLK = 64, LDQ = 192, LDK = 192, LDV = 128;
constexpr float SCALE = 0.07216878364870323f, THR = 8.f;
constexpr int SHM_V = KVBLK * 128 * 2, SHM_K = KVBLK * 400;
#define KSWZ(row, colB) ((row) * 400 + (colB))
#define SBAR() __builtin_amdgcn_sched_barrier(0)
__device__ __forceinline__ int crow(int r, int hi) { return (r & 3) + 8 * (r >> 2) + 4 * hi; }
__device__ __forceinline__ void partialSM(f32x16& p0, f32x16& p1, float& m_reg, float& mn, float& alpha) {
  constexpr float C = SCALE * 1.4426950408889634f;
  float pmax = p0[0];
#pragma unroll
  for (int r = 1; r < 16; ++r) pmax = fmaxf(pmax, p0[r]);
#pragma unroll
  for (int r = 0; r < 16; ++r) pmax = fmaxf(pmax, p1[r]);
  { auto rr = __builtin_amdgcn_permlane32_swap(__float_as_uint(pmax), __float_as_uint(pmax), false, false);
    pmax = fmaxf(__uint_as_float(rr[0]), __uint_as_float(rr[1])); }
  if (__builtin_expect(__all(pmax - m_reg <= THR / SCALE), 1)) { mn = m_reg; alpha = 1.f; }
  else { mn = fmaxf(m_reg, pmax); alpha = __builtin_amdgcn_exp2f((m_reg - mn) * C); m_reg = mn; }
  const float mnC = -mn * C;
#pragma unroll
  for (int r = 0; r < 16; ++r) p0[r] = fmaf(p0[r], C, mnC);
#pragma unroll
  for (int r = 0; r < 16; ++r) p1[r] = fmaf(p1[r], C, mnC);
#pragma unroll
  for (int r = 0; r < 16; ++r) p0[r] = __builtin_amdgcn_exp2f(p0[r]);
}
__device__ __forceinline__ void finishSM(f32x16& p0, f32x16& p1, float alpha, float& l_reg, bf16x8& pa0, bf16x8& pa1, bf16x8& pa2, bf16x8& pa3) {
#pragma unroll
  for (int r = 0; r < 16; ++r) p1[r] = __builtin_amdgcn_exp2f(p1[r]);
  float ps = 0;
#pragma unroll
  for (int r = 0; r < 16; ++r) ps += p0[r];
#pragma unroll
  for (int r = 0; r < 16; ++r) ps += p1[r];
  { auto rr = __builtin_amdgcn_permlane32_swap(__float_as_uint(ps), __float_as_uint(ps), false, false);
    ps = __uint_as_float(rr[0]) + __uint_as_float(rr[1]); }
  l_reg = l_reg * alpha + ps;
#define PK4(PP, BASE, OUT) do { unsigned a0 = cvtpk(PP[BASE + 0], PP[BASE + 1]), a1 = cvtpk(PP[BASE + 2], PP[BASE + 3]);   \
    unsigned b0 = cvtpk(PP[BASE + 4], PP[BASE + 5]), b1 = cvtpk(PP[BASE + 6], PP[BASE + 7]);                              \
    auto r0 = __builtin_amdgcn_permlane32_swap(a0, b0, false, false); auto r1 = __builtin_amdgcn_permlane32_swap(a1, b1, false, false); \
    u32x4 w = {r0[0], r1[0], r0[1], r1[1]}; OUT = *reinterpret_cast<bf16x8*>(&w); } while (0)
  PK4(p0, 0, pa0); PK4(p0, 8, pa1); PK4(p1, 0, pa2); PK4(p1, 8, pa3);
#undef PK4
}
__device__ __forceinline__ void qkt(f32x16& p0, f32x16& p1, const char* Ks, const bf16x8* qr, const char* qlds, int r32, int hi) {
  p0 = f32x16{}; p1 = f32x16{};
#pragma unroll
  for (int d0 = 0; d0 < 12; ++d0) { const int cb = (d0 * 16 + hi * 8) * 2;
    const bf16x8 b0 = *reinterpret_cast<const bf16x8*>(Ks + KSWZ(r32, cb));
    const bf16x8 b1 = *reinterpret_cast<const bf16x8*>(Ks + KSWZ(32 + r32, cb));
    const bf16x8 qv = d0 < 8 ? qr[d0 < 8 ? d0 : 0] : *reinterpret_cast<const bf16x8*>(qlds + (d0 - 8) * 1024);
    p0 = __builtin_amdgcn_mfma_f32_32x32x16_bf16(b0, qv, p0, 0, 0, 0);
    p1 = __builtin_amdgcn_mfma_f32_32x32x16_bf16(b1, qv, p1, 0, 0, 0); }
}
__device__ __forceinline__ int v_st(int k, int c) { const int kk = (k & ~0xC) | ((k & 4) << 1) | ((k & 8) >> 1); return ((kk >> 3) * 4 + (c >> 5)) * 512 + ((kk & 7) * 32 + (c & 31)) * 2; }
__device__ __forceinline__ int v_rd_base(int lane) { return ((lane & 3) << 3) | (((lane >> 2) & 3) << 6) | (((lane >> 4) & 1) << 5) | (((lane >> 5) & 1) << 8); }
constexpr int v_rd_off(int d0, int ks, int half) { return d0 * 512 + ks * 4096 + half * 2048; }
template <int OFF> __device__ __forceinline__ s16x4 tr_read(int vb) {
  s16x4 r; asm volatile("ds_read_b64_tr_b16 %0, %1 offset:%2" : "=&v"(r) : "v"(vb), "i"(OFF) : "memory"); return r;
}
template <int D0> __device__ __forceinline__ void pv_one(f32x16& od, int vb, bf16x8 pa0, bf16x8 pa1, bf16x8 pa2, bf16x8 pa3) {
  const s16x4 l0 = tr_read<v_rd_off(D0, 0, 0)>(vb), h0 = tr_read<v_rd_off(D0, 0, 1)>(vb), l1 = tr_read<v_rd_off(D0, 1, 0)>(vb), h1 = tr_read<v_rd_off(D0, 1, 1)>(vb);
  const s16x4 l2 = tr_read<v_rd_off(D0, 2, 0)>(vb), h2 = tr_read<v_rd_off(D0, 2, 1)>(vb), l3 = tr_read<v_rd_off(D0, 3, 0)>(vb), h3 = tr_read<v_rd_off(D0, 3, 1)>(vb);
  asm volatile("s_waitcnt lgkmcnt(0)" ::: "memory"); SBAR();
#define PK(L, H) (bf16x8){L[0], L[1], L[2], L[3], H[0], H[1], H[2], H[3]}
  od = __builtin_amdgcn_mfma_f32_32x32x16_bf16(pa0, PK(l0, h0), od, 0, 0, 0);
  od = __builtin_amdgcn_mfma_f32_32x32x16_bf16(pa1, PK(l1, h1), od, 0, 0, 0);
  od = __builtin_amdgcn_mfma_f32_32x32x16_bf16(pa2, PK(l2, h2), od, 0, 0, 0);
  od = __builtin_amdgcn_mfma_f32_32x32x16_bf16(pa3, PK(l3, h3), od, 0, 0, 0);
#undef PK
}
__device__ __forceinline__ void pv_d0(f32x16* o, int vb, bf16x8 pa0, bf16x8 pa1, bf16x8 pa2, bf16x8 pa3) {
  pv_one<0>(o[0], vb, pa0, pa1, pa2, pa3); pv_one<1>(o[1], vb, pa0, pa1, pa2, pa3); pv_one<2>(o[2], vb, pa0, pa1, pa2, pa3); pv_one<3>(o[3], vb, pa0, pa1, pa2, pa3);
}
__device__ __forceinline__ void attn_body(const bf16_t* __restrict__ Qb, const bf16_t* __restrict__ Kh, const bf16_t* __restrict__ Vh, bf16_t* __restrict__ Ob, int seq, char* lds, int wv_) {
  const int tid = TIDX, wid = tid >> 6, lane = tid & 63, r32 = lane & 31, hi = lane >> 5;
  char* V_lds = lds; char* K_lds = lds + 2 * SHM_V;
  float* wsf = (float*)(lds + 2 * SHM_V + 2 * SHM_K) + wid * 64; float* li_l = wsf; float* al_l = wsf + 32;
  float m_reg = -1e30f, l_reg = 0; f32x16 o[4] = {}; bf16x8 qr[8];
  const int qoff = ((wid * QBLK + r32) * LDQ + hi * 8) * 2;
  const int qlo = 2 * SHM_V + 2 * SHM_K + 2048 + wid * 4096 + lane * 16;
#pragma unroll
  for (int d0 = 0; d0 < 8; ++d0) qr[d0] = *reinterpret_cast<const bf16x8*>((const char*)Qb + qoff + d0 * 32);
#pragma unroll
  for (int d0 = 8; d0 < 12; ++d0) *reinterpret_cast<bf16x8*>(lds + qlo + (d0 - 8) * 1024) = *reinterpret_cast<const bf16x8*>((const char*)Qb + qoff + d0 * 32);
  const int sr = tid >> 4, sc = (tid & 15) * 8, vst0 = v_st(sr, sc);
  const int kr0 = tid >> 3, kc0 = (tid & 7) * 8, ksw0 = KSWZ(kr0, kc0 * 2);
  const int vb0 = (int)(uintptr_t)V_lds + v_rd_base(lane);
  bf16x8 vs0, vs1, ks0, ks1, ks2;
  const int vo0 = (sr * LDV + sc) * 2, ko0 = (kr0 * LDK + kc0) * 2;
#define SLOAD(k0) do { const char* vt_ = (const char*)Vh + (size_t)(k0) * (LDV * 2); const char* kt_ = (const char*)Kh + (size_t)(k0) * (LDK * 2); \
    vs0 = *(const bf16x8*)(vt_ + vo0); vs1 = *(const bf16x8*)(vt_ + vo0 + 32 * LDV * 2); \
    ks0 = *(const bf16x8*)(kt_ + ko0); ks1 = *(const bf16x8*)(kt_ + ko0 + 128); ks2 = *(const bf16x8*)(kt_ + ko0 + 256); } while (0)
#define SWRITE(b) do { *(bf16x8*)(V_lds + (b) * SHM_V + vst0) = vs0; *(bf16x8*)(V_lds + (b) * SHM_V + vst0 + 8192) = vs1; \
    *(bf16x8*)(K_lds + (b) * SHM_K + ksw0) = ks0; *(bf16x8*)(K_lds + (b) * SHM_K + ksw0 + 128) = ks1; *(bf16x8*)(K_lds + (b) * SHM_K + ksw0 + 256) = ks2; } while (0)
#define SWAIT() asm volatile("s_waitcnt vmcnt(0)" ::: "memory")
#define RESC(a) do { if (__any((a) < 1.f)) { if (hi == 0) al_l[r32] = (a); asm volatile("s_waitcnt lgkmcnt(0)" ::: "memory"); \
    _Pragma("unroll") for (int d = 0; d < 4; ++d) _Pragma("unroll") for (int r = 0; r < 16; ++r) o[d][r] *= al_l[crow(r, hi)]; } } while (0)
  f32x16 pA0, pA1, pB0, pB1; float mnA, mnB, alA, alB; bf16x8 pa0, pa1, pa2, pa3; constexpr int NT = 260;
  SLOAD(0); SWAIT(); SWRITE(0); __syncthreads();
  qkt(pA0, pA1, K_lds, qr, lds + qlo, r32, hi); partialSM(pA0, pA1, m_reg, mnA, alA);
  SLOAD(KVBLK);
  SWAIT(); SWRITE(1); __syncthreads();
  for (int j = 1; j + 1 < NT; j += 2) {
    SBAR(); qkt(pB0, pB1, K_lds + SHM_K, qr, lds + qlo, r32, hi);
    finishSM(pA0, pA1, alA, l_reg, pa0, pa1, pa2, pa3); SBAR();
    SLOAD((j + 1) * KVBLK); SBAR();
    pv_d0(o, vb0, pa0, pa1, pa2, pa3); partialSM(pB0, pB1, m_reg, mnB, alB);
    __syncthreads(); SWAIT(); SWRITE(0);
    RESC(alB); __syncthreads();
    SBAR(); qkt(pA0, pA1, K_lds, qr, lds + qlo, r32, hi);
    finishSM(pB0, pB1, alB, l_reg, pa0, pa1, pa2, pa3); SBAR();
    SLOAD((j + 2) * KVBLK); SBAR();
    pv_d0(o, vb0 + SHM_V, pa0, pa1, pa2, pa3); partialSM(pA0, pA1, m_reg, mnA, alA);
    __syncthreads(); SWAIT(); SWRITE(1);
    RESC(alA); __syncthreads();
  }
  SBAR(); qkt(pB0, pB1, K_lds + SHM_K, qr, lds + qlo, r32, hi);
  finishSM(pA0, pA1, alA, l_reg, pa0, pa1, pa2, pa3); SBAR();
  pv_d0(o, vb0, pa0, pa1, pa2, pa3); partialSM(pB0, pB1, m_reg, mnB, alB);
  __syncthreads(); RESC(alB);
  finishSM(pB0, pB1, alB, l_reg, pa0, pa1, pa2, pa3); SBAR();
  pv_d0(o, vb0 + SHM_V, pa0, pa1, pa2, pa3);
  if (hi == 0) li_l[r32] = l_reg; asm volatile("s_waitcnt lgkmcnt(0)" ::: "memory");
  float rli[16];
#pragma unroll
  for (int r = 0; r < 16; ++r) rli[r] = __builtin_amdgcn_rcpf(li_l[crow(r, hi)]);
#pragma unroll
  for (int r = 0; r < 16; ++r) { const int ooff = ((wid * QBLK + crow(r, hi)) * 2048 + r32) * 2;
#pragma unroll
    for (int d0 = 0; d0 < 4; ++d0) *(bf16_t*)((char*)Ob + ooff + d0 * 64) = f2bf(o[d0][r] * rli[r]); }
  __syncthreads();
#undef SLOAD
#undef SWRITE
#undef SWAIT
#undef RESC
}
}

__device__ __forceinline__ void phase_attn(CP& p, char* lds, int wv_) {
  for (int u = blockIdx.x; u < 1024; u += gridDim.x) {
    const int qb = u & 63, bh = u >> 6, b = bh >> 3, h = bh & 7;
    const bf16_t* Q = (const bf16_t*)(p.ws + O_Q) + ((size_t)bh * 16384 + qb * 256) * 192;
    const bf16_t* K = (const bf16_t*)(p.ws + O_K) + (size_t)bh * 16640 * 192;
    const bf16_t* V = (const bf16_t*)(p.ws + O_V) + (size_t)bh * 16640 * 128;
    bf16_t* O = (bf16_t*)((char*)p.out + DO_YCAT) + ((size_t)b * 16384 + qb * 256) * 2048 + h * 128;
    att::attn_body(Q, K, V, O, 16640, lds, wv_);
  }
}

__device__ __forceinline__ void phase_glu(CP& p, int wv_) {
  bf16_t* H = (bf16_t*)(p.ws + O_H); const float* cw = p.in[I_FCONV]; const float* side = (const float*)(p.ws + O_SIDE);
  const int total = 2 * 512 * 5504;
  for (int id = blockIdx.x * 512 + TIDX; id < total; id += gridDim.x * 512) {
    const int type = id / (512 * 5504), rem = id - type * (512 * 5504), rb = rem / 5504, c = rem - rb * 5504;
    const int r = rb * 64 + (type ? 63 : 0), t = r & 16383;
    if (type == 0 ? (t == 0) : (t == 16383)) continue;
    const float* sp = side + ((size_t)(type * 512 + rb) * 3) * 5504 + c;
    const float gnb = type == 0 ? side[((size_t)(1 * 512 + rb - 1) * 3 + 2) * 5504 + c] : side[((size_t)(0 * 512 + rb + 1) * 3 + 2) * 5504 + c];
    const float cv = sp[0] + cw[(type ? 2 : 0) * 5504 + c] * gnb;
    H[(size_t)r * 5504 + c] = f2bf(silu_f(cv) * sp[5504]);
  }
}

#define XB_TMO      128
#define XB_XCNT(j)  (256  + 64 * (j))
#define XB_XSUB(j)  (1280 + 64 * (j))
#define XB_XGEN(j)  (2304 + 64 * (j))
#define XB_TOP      3328
#define XB_TOPGEN   3392
#define XCD_BAR_WORDS 3456
#define XB_SPIN_CAP (1u << 22)
__device__ __forceinline__ unsigned xb_ld(unsigned* p)              { return __hip_atomic_load(p, __ATOMIC_RELAXED, __HIP_MEMORY_SCOPE_AGENT); }
__device__ __forceinline__ unsigned xb_add(unsigned* p, unsigned v) { return __hip_atomic_fetch_add(p, v, __ATOMIC_RELAXED, __HIP_MEMORY_SCOPE_AGENT); }
__device__ __forceinline__ unsigned xb_xcc_id() { return (unsigned)__builtin_amdgcn_s_getreg((3 << 11) | 20) & 0xFu; }
#define XB_SPIN(cond, bar) do { unsigned _sp = 0; while (cond) { __builtin_amdgcn_s_sleep(1); \
    if ((++_sp & 255u) == 0u) { if (xb_ld(&(bar)[XB_TMO])) break; if (_sp > XB_SPIN_CAP) { atomicAdd(&(bar)[XB_TMO], 1u); break; } } } } while (0)
__device__ __forceinline__ void xcd_barrier_complete(unsigned* bar, unsigned x, unsigned& nloc, unsigned& nx) {
  const unsigned G = gridDim.x;
  unsigned sum, cnt, mine, sp = 0u;
  for (;;) {
    sum = 0u; cnt = 0u; mine = 0u;
#pragma unroll
    for (unsigned j = 0; j < 16; ++j) { const unsigned c = xb_ld(&bar[XB_XCNT(j)]); sum += c; cnt += (c > 0u) ? 1u : 0u; mine = (j == x) ? c : mine; }
    if (sum == G) break;
    __builtin_amdgcn_s_sleep(1);
    if ((++sp & 255u) == 0u) { if (xb_ld(&bar[XB_TMO])) break; if (sp > XB_SPIN_CAP) { atomicAdd(&bar[XB_TMO], 1u); break; } }
  }
  nloc = mine > 0u ? mine : 1u; nx = cnt > 0u ? cnt : 1u;
}
__device__ __forceinline__ void gsync(unsigned* bar, unsigned xcc, volatile LAS unsigned* st, int wv_) {
  asm volatile("s_waitcnt vmcnt(0)" ::: "memory");
  __syncthreads();
  if (wv_ == 0 && lane_id_v() == 0) {
    __builtin_amdgcn_s_waitcnt(0);
    unsigned nloc = st[0], nx = st[1];
    if (nloc == 0u) { xcd_barrier_complete(bar, xcc, nloc, nx); st[0] = nloc; st[1] = nx; }
    const unsigned old = xb_add(&bar[XB_XSUB(xcc)], 1u);
    const unsigned gen = old / nloc;
    if (old + 1u == (gen + 1u) * nloc) {
      __builtin_amdgcn_fence(__ATOMIC_RELEASE, "agent");
      asm volatile("s_waitcnt vmcnt(0)" ::: "memory");
      const unsigned og = xb_add(&bar[XB_TOP], 1u);
      const unsigned tg = og / nx;
      if (og + 1u == (tg + 1u) * nx) xb_add(&bar[XB_TOPGEN], 1u);
      else XB_SPIN(xb_ld(&bar[XB_TOPGEN]) == tg, bar);
      __builtin_amdgcn_fence(__ATOMIC_ACQUIRE, "agent");
      xb_add(&bar[XB_XGEN(xcc)], 1u);
      asm volatile("s_waitcnt vmcnt(0)" ::: "memory");
    } else {
      XB_SPIN(xb_ld(&bar[XB_XGEN(xcc)]) == gen, bar);
      __builtin_amdgcn_fence(__ATOMIC_ACQUIRE, "agent");
      asm volatile("s_waitcnt vmcnt(0)" ::: "memory");
    }
  }
  __syncthreads();
}

#if DBG
__device__ __forceinline__ void chk16(const void* ptr, size_t nelem, unsigned* flag, unsigned code, int wv_) {
  const u32x4* q = (const u32x4*)ptr; const size_t n = nelem / 8; bool bad = false;
  for (size_t i = (size_t)blockIdx.x * 512 + TIDX; i < n; i += (size_t)gridDim.x * 512) { const u32x4 w = q[i];
#pragma unroll
    for (int e = 0; e < 4; ++e) { const unsigned a = w[e] & 0x7F80u, b = (w[e] >> 16) & 0x7F80u; if (a >= (141u << 7) || b >= (141u << 7)) bad = true; } }
  if (bad) atomicMax(flag, 32u - code);
}
__device__ __forceinline__ void chk32(const void* ptr, size_t nelem, unsigned* flag, unsigned code, int wv_) {
  const unsigned* q = (const unsigned*)ptr; bool bad = false;
  for (size_t i = (size_t)blockIdx.x * 512 + TIDX; i < nelem; i += (size_t)gridDim.x * 512) { const unsigned a = (q[i] >> 23) & 0xFFu; if (a >= 141u) bad = true; }
  if (bad) atomicMax(flag, 32u - code);
}
__device__ void dbg_check(CP& p, int ph, int wv_) {
  unsigned* flag = (unsigned*)(p.ws + O_BAR) + 16; char* ws = p.ws;
  switch (ph) {
    case 0: chk32(ws + O_MOD, 36864, flag, 1, wv_); chk16(ws + O_WIN, 9472ull * 2048, flag, 1, wv_); chk16(ws + O_WUP, 11008ull * 2048, flag, 1, wv_); chk16(ws + O_WDN, 2048ull * 5504, flag, 1, wv_); chk16(ws + O_WQB, (O_WUP - O_WQB) / 2, flag, 1, wv_); break;
    case 1: chk16(ws + O_XN, NROW * 2048, flag, 2, wv_); break;
    case 2: chk16(ws + O_QKVA, NROW * 1024, flag, 3, wv_); chk16(ws + O_DQKV, NROW * 3072, flag, 3, wv_); chk16(ws + O_ZG, NROW * 5120, flag, 3, wv_); chk32(ws + O_MISC, NROW * 96, flag, 3, wv_); break;
    case 3: chk16(ws + O_QN, NLAT * 1024, flag, 4, wv_); chk16(ws + O_KN, NROW * 1024, flag, 4, wv_); chk16(ws + O_VN, NROW * 1024, flag, 4, wv_); chk32(ws + O_G, 2ull * 2 * 8 * 16640 * 2, flag, 4, wv_); chk32(ws + O_RSTD, NROW * 2, flag, 4, wv_); break;
    case 4: chk16(p.out, 4ull * 32768 * 1024, flag, 5, wv_); chk16(ws + O_UC, 2ull * 2 * 2 * 256 * 1024, flag, 5, wv_); chk32(ws + O_GC, 2ull * 2 * 8 * 16640, flag, 5, wv_); break;
    case 5: { const u32x4* q = (const u32x4*)(ws + O_OSC); const size_t n = 2ull * 32768 * 1024 / 8; unsigned cnt = 0, mn = 0xFFFFFFFFu;
      for (size_t i = (size_t)blockIdx.x * 512 + TIDX; i < n; i += (size_t)gridDim.x * 512) { const u32x4 w = q[i];
        for (int e = 0; e < 4; ++e) { const unsigned a = w[e] & 0x7F80u, b = (w[e] >> 16) & 0x7F80u; if (a >= (141u << 7)) { cnt++; mn = min(mn, (unsigned)(i * 8 + e * 2)); } if (b >= (141u << 7)) { cnt++; mn = min(mn, (unsigned)(i * 8 + e * 2 + 1)); } } }
      if (cnt) { atomicMax(flag, 32u - 6u); atomicAdd(flag + 4, cnt); atomicMax(flag + 5, 0xFFFFFFFFu - mn); } } break;
    case 6: chk16(p.out, NLAT * 1536, flag, 7, wv_); chk16(ws + O_KVRAW, NROW * 2048, flag, 7, wv_); break;
    case 7: chk16(ws + O_Q, 2ull * 8 * 16384 * 192, flag, 8, wv_); chk16(ws + O_K, 2ull * 8 * 16640 * 192, flag, 8, wv_); chk16(ws + O_V, 2ull * 8 * 16640 * 128, flag, 8, wv_); break;
    case 8: chk16((char*)p.out + DO_YCAT, NLAT * 2048, flag, 9, wv_); break;
    case 9: chk16(ws + O_MERGED, NLAT * 2048, flag, 10, wv_); break;
    case 10: chk32(p.out, NLAT * 2048, flag, 11, wv_); break;
    case 11: chk16(ws + O_XN2, NLAT * 2048, flag, 12, wv_); break;
    case 12: chk16(ws + O_H, NLAT * 11008, flag, 13, wv_); break;
    case 13: chk16(ws + O_H, NLAT * 11008, flag, 14, wv_); break;
    case 14: chk32(p.out, NLAT * 2048, flag, 15, wv_); break;
  }
}
#endif
__global__ void __launch_bounds__(512) mega(P p_unused, int ph_lo, int ph_hi) {
  extern __shared__ __attribute__((aligned(16))) unsigned char lds_raw[];
  LAS unsigned char* ldsl = (LAS unsigned char*)lds_raw; char* lds = (char*)lds_raw;
  cg::grid_group grid = cg::this_grid();
  const int wv_ = __builtin_amdgcn_readfirstlane((int)(threadIdx.x >> 6));
  volatile LAS unsigned* xst_ = (volatile LAS unsigned*)(ldsl + 143344);
  const unsigned xcc_ = xb_xcc_id();
  if (threadIdx.x == 0) { xst_[0] = 0u; xst_[1] = 0u; (void)xb_add((unsigned*)(p_unused.ws + O_BAR) + XB_XCNT(xcc_), 1u); }
  __syncthreads();
  CP* kp0 = (CP*)__builtin_amdgcn_kernarg_segment_ptr();
#define PP() (*({ CP* q_ = kp0; asm volatile("" : "+s"(q_)); q_; }))
  if (ph_lo <= 0 && 0 <= ph_hi) { CP& p = PP(); phase_prep(p, lds, wv_); if (REP == 0) { phase_prep(p, lds, wv_, 384); } if (0 < ph_hi) grid.sync(); }
#if DBG
  { gsync((unsigned*)(PP().ws + O_BAR) + 32, (unsigned)(2 * 0 + 1) * gridDim.x, wv_); CP& p = PP(); dbg_check(p, 0, wv_); gsync((unsigned*)(PP().ws + O_BAR) + 32, (unsigned)(2 * 0 + 2) * gridDim.x, wv_); }
#endif
  if (ph_lo <= 1 && 1 <= ph_hi) { CP& p = PP(); phase_normmod<0>(p, wv_); if (REP == 1) { phase_normmod<0>(p, wv_); } if (1 < ph_hi) gsync((unsigned*)(PP().ws + O_BAR), xcc_, xst_, wv_); }
#if DBG
  { gsync((unsigned*)(PP().ws + O_BAR) + 32, (unsigned)(2 * 1 + 1) * gridDim.x, wv_); CP& p = PP(); dbg_check(p, 1, wv_); gsync((unsigned*)(PP().ws + O_BAR) + 32, (unsigned)(2 * 1 + 2) * gridDim.x, wv_); }
#endif
  if (ph_lo <= 2 && 2 <= ph_hi) { CP& p = PP(); { gm::JobInproj J; J.A = p.ws + O_XN; J.B = p.ws + O_WIN; J.K = 2048; J.lda = 2048; J.ldb = 2048; J.nM = 130; J.nN = 37; J.ws = p.ws; gm::gemm_phase(ldsl, J, wv_); } if (REP == 2) { { gm::JobInproj J; J.A = p.ws + O_XN; J.B = p.ws + O_WIN; J.K = 2048; J.lda = 2048; J.ldb = 2048; J.nM = 130; J.nN = 37; J.ws = p.ws; gm::gemm_phase(ldsl, J, wv_); } } if (2 < ph_hi) gsync((unsigned*)(PP().ws + O_BAR), xcc_, xst_, wv_); }
#if DBG
  { gsync((unsigned*)(PP().ws + O_BAR) + 32, (unsigned)(2 * 2 + 1) * gridDim.x, wv_); CP& p = PP(); dbg_check(p, 2, wv_); gsync((unsigned*)(PP().ws + O_BAR) + 32, (unsigned)(2 * 2 + 2) * gridDim.x, wv_); }
#endif
  if (ph_lo <= 3 && 3 <= ph_hi) { CP& p = PP(); phase_dnprep(p, wv_); if (REP == 3) { phase_dnprep(p, wv_); } if (3 < ph_hi) gsync((unsigned*)(PP().ws + O_BAR), xcc_, xst_, wv_); }
#if DBG
  { gsync((unsigned*)(PP().ws + O_BAR) + 32, (unsigned)(2 * 3 + 1) * gridDim.x, wv_); CP& p = PP(); dbg_check(p, 3, wv_); gsync((unsigned*)(PP().ws + O_BAR) + 32, (unsigned)(2 * 3 + 2) * gridDim.x, wv_); }
#endif
  if (ph_lo <= 4 && 4 <= ph_hi) { CP& p = PP(); phase_chunk(p, lds, wv_); if (REP == 4) { phase_chunk(p, lds, wv_); } if (4 < ph_hi) gsync((unsigned*)(PP().ws + O_BAR), xcc_, xst_, wv_); }
#if DBG
  { gsync((unsigned*)(PP().ws + O_BAR) + 32, (unsigned)(2 * 4 + 1) * gridDim.x, wv_); CP& p = PP(); dbg_check(p, 4, wv_); gsync((unsigned*)(PP().ws + O_BAR) + 32, (unsigned)(2 * 4 + 2) * gridDim.x, wv_); }
#endif
  if (ph_lo <= 5 && 5 <= ph_hi) { CP& p = PP(); phase_scan(p, lds, wv_); if (REP == 5) { phase_scan(p, lds, wv_); } if (5 < ph_hi) gsync((unsigned*)(PP().ws + O_BAR), xcc_, xst_, wv_); }
#if DBG
  { gsync((unsigned*)(PP().ws + O_BAR) + 32, (unsigned)(2 * 5 + 1) * gridDim.x, wv_); CP& p = PP(); dbg_check(p, 5, wv_); gsync((unsigned*)(PP().ws + O_BAR) + 32, (unsigned)(2 * 5 + 2) * gridDim.x, wv_); }
#endif
  if (ph_lo <= 6 && 6 <= ph_hi) { CP& p = PP(); { gm::JobPlain J; J.A = p.ws + O_QKVA; J.B = p.ws + O_WQB; J.K = 512; J.lda = 1024; J.ldb = 512; J.nM = 128; J.nN = 6; J.O = (bf16_t*)p.out; J.ldc = 1536; gm::gemm_phase(ldsl, J, wv_);
#if DBG
  { gsync((unsigned*)(PP().ws + O_BAR) + 32, (unsigned)(2 * 6 + 1) * gridDim.x, wv_); CP& p = PP(); dbg_check(p, 6, wv_); gsync((unsigned*)(PP().ws + O_BAR) + 32, (unsigned)(2 * 6 + 2) * gridDim.x, wv_); }
#endif
                gm::JobKV J2; J2.A = p.ws + O_QKVA + 1024; J2.B = p.ws + O_WKVB; J2.K = 512; J2.lda = 1024; J2.ldb = 512; J2.nM = 130; J2.nN = 8; J2.O = (bf16_t*)(p.ws + O_KVRAW); J2.V = (bf16_t*)(p.ws + O_V); J2.rstd = (const float*)(p.ws + O_RSTD); gm::gemm_phase(ldsl, J2, wv_); } if (6 < ph_hi) gsync((unsigned*)(PP().ws + O_BAR), xcc_, xst_, wv_); }
  if (ph_lo <= 7 && 7 <= ph_hi) { CP& p = PP(); phase_mlafin(p, wv_); if (REP == 7) { phase_mlafin(p, wv_); } if (7 < ph_hi) gsync((unsigned*)(PP().ws + O_BAR), xcc_, xst_, wv_); }
#if DBG
  { gsync((unsigned*)(PP().ws + O_BAR) + 32, (unsigned)(2 * 7 + 1) * gridDim.x, wv_); CP& p = PP(); dbg_check(p, 7, wv_); gsync((unsigned*)(PP().ws + O_BAR) + 32, (unsigned)(2 * 7 + 2) * gridDim.x, wv_); }
#endif
  if (ph_lo <= 8 && 8 <= ph_hi) { CP& p = PP(); phase_attn(p, lds, wv_); if (REP == 8) { phase_attn(p, lds, wv_); } if (8 < ph_hi) gsync((unsigned*)(PP().ws + O_BAR), xcc_, xst_, wv_); }
#if DBG
  { gsync((unsigned*)(PP().ws + O_BAR) + 32, (unsigned)(2 * 8 + 1) * gridDim.x, wv_); CP& p = PP(); dbg_check(p, 8, wv_); gsync((unsigned*)(PP().ws + O_BAR) + 32, (unsigned)(2 * 8 + 2) * gridDim.x, wv_); }
#endif
  if (ph_lo <= 9 && 9 <= ph_hi) { CP& p = PP(); { gm::JobMerge J; J.A = (const char*)p.out + DO_YCAT; J.B = p.ws + O_WCAT; J.K = 1024; J.lda = 2048; J.ldb = 2048; J.nM = 128; J.nN = 8; J.ZG = (const bf16_t*)(p.ws + O_ZG); J.O = (bf16_t*)(p.ws + O_MERGED); gm::gemm_phase(ldsl, J, wv_); } if (REP == 9) { { gm::JobMerge J; J.A = (const char*)p.out + DO_YCAT; J.B = p.ws + O_WCAT; J.K = 1024; J.lda = 2048; J.ldb = 2048; J.nM = 128; J.nN = 8; J.ZG = (const bf16_t*)(p.ws + O_ZG); J.O = (bf16_t*)(p.ws + O_MERGED); gm::gemm_phase(ldsl, J, wv_); } } if (9 < ph_hi) gsync((unsigned*)(PP().ws + O_BAR), xcc_, xst_, wv_); }
#if DBG
  { gsync((unsigned*)(PP().ws + O_BAR) + 32, (unsigned)(2 * 9 + 1) * gridDim.x, wv_); CP& p = PP(); dbg_check(p, 9, wv_); gsync((unsigned*)(PP().ws + O_BAR) + 32, (unsigned)(2 * 9 + 2) * gridDim.x, wv_); }
#endif
  if (ph_lo <= 10 && 10 <= ph_hi) { CP& p = PP(); { gm::JobResid J; J.A = p.ws + O_MERGED; J.B = p.ws + O_WOUT; J.K = 2048; J.lda = 2048; J.ldb = 2048; J.nM = 128; J.nN = 8; J.base = p.in[I_X]; J.gate = (const float*)(p.ws + O_MOD) + 2 * 2048; J.out = p.out; gm::gemm_phase(ldsl, J, wv_); } if (REP == 10) { { gm::JobResid J; J.A = p.ws + O_MERGED; J.B = p.ws + O_WOUT; J.K = 2048; J.lda = 2048; J.ldb = 2048; J.nM = 128; J.nN = 8; J.base = p.in[I_X]; J.gate = (const float*)(p.ws + O_MOD) + 2 * 2048; J.out = p.out; gm::gemm_phase(ldsl, J, wv_); } } if (10 < ph_hi) gsync((unsigned*)(PP().ws + O_BAR), xcc_, xst_, wv_); }
#if DBG
  { gsync((unsigned*)(PP().ws + O_BAR) + 32, (unsigned)(2 * 10 + 1) * gridDim.x, wv_); CP& p = PP(); dbg_check(p, 10, wv_); gsync((unsigned*)(PP().ws + O_BAR) + 32, (unsigned)(2 * 10 + 2) * gridDim.x, wv_); }
#endif
  if (ph_lo <= 11 && 11 <= ph_hi) { CP& p = PP(); phase_normmod<1>(p, wv_); if (REP == 11) { phase_normmod<1>(p, wv_); } if (11 < ph_hi) gsync((unsigned*)(PP().ws + O_BAR), xcc_, xst_, wv_); }
#if DBG
  { gsync((unsigned*)(PP().ws + O_BAR) + 32, (unsigned)(2 * 11 + 1) * gridDim.x, wv_); CP& p = PP(); dbg_check(p, 11, wv_); gsync((unsigned*)(PP().ws + O_BAR) + 32, (unsigned)(2 * 11 + 2) * gridDim.x, wv_); }
#endif
  if (ph_lo <= 12 && 12 <= ph_hi) { CP& p = PP(); { gm::JobUpGlu J; J.A = p.ws + O_XN2; J.B = p.ws + O_WUP; J.K = 2048; J.lda = 2048; J.ldb = 2048; J.nM = 128; J.nN = 43; J.O = (bf16_t*)(p.ws + O_H); J.cw = p.in[I_FCONV]; J.side = (float*)(p.ws + O_SIDE); gm::gemm_phase(ldsl, J, wv_); } if (REP == 12) { { gm::JobUpGlu J; J.A = p.ws + O_XN2; J.B = p.ws + O_WUP; J.K = 2048; J.lda = 2048; J.ldb = 2048; J.nM = 128; J.nN = 43; J.O = (bf16_t*)(p.ws + O_H); J.cw = p.in[I_FCONV]; J.side = (float*)(p.ws + O_SIDE); gm::gemm_phase(ldsl, J, wv_); } } if (12 < ph_hi) gsync((unsigned*)(PP().ws + O_BAR), xcc_, xst_, wv_); }
#if DBG
  { gsync((unsigned*)(PP().ws + O_BAR) + 32, (unsigned)(2 * 12 + 1) * gridDim.x, wv_); CP& p = PP(); dbg_check(p, 12, wv_); gsync((unsigned*)(PP().ws + O_BAR) + 32, (unsigned)(2 * 12 + 2) * gridDim.x, wv_); }
#endif
  if (ph_lo <= 13 && 13 <= ph_hi) { CP& p = PP(); phase_glu(p, wv_); if (REP == 13) { phase_glu(p, wv_); } if (13 < ph_hi) gsync((unsigned*)(PP().ws + O_BAR), xcc_, xst_, wv_); }
#if DBG
  { gsync((unsigned*)(PP().ws + O_BAR) + 32, (unsigned)(2 * 13 + 1) * gridDim.x, wv_); CP& p = PP(); dbg_check(p, 13, wv_); gsync((unsigned*)(PP().ws + O_BAR) + 32, (unsigned)(2 * 13 + 2) * gridDim.x, wv_); }
#endif
  if (ph_lo <= 14 && 14 <= ph_hi) { CP& p = PP(); { gm::JobResid J; J.A = p.ws + O_H; J.B = p.ws + O_WDN; J.K = 5504; J.lda = 5504; J.ldb = 5504; J.nM = 128; J.nN = 8; J.base = p.out; J.gate = (const float*)(p.ws + O_MOD) + 5 * 2048; J.out = p.out; gm::gemm_phase(ldsl, J, wv_); } if (REP == 14) { { gm::JobResid J; J.A = p.ws + O_H; J.B = p.ws + O_WDN; J.K = 5504; J.lda = 5504; J.ldb = 5504; J.nM = 128; J.nN = 8; J.base = p.out; J.gate = (const float*)(p.ws + O_MOD) + 5 * 2048; J.out = p.out; gm::gemm_phase(ldsl, J, wv_); } } if (14 < ph_hi) gsync((unsigned*)(PP().ws + O_BAR), xcc_, xst_, wv_); }
#if DBG
  { gsync((unsigned*)(PP().ws + O_BAR) + 32, (unsigned)(2 * 14 + 1) * gridDim.x, wv_); CP& p = PP(); dbg_check(p, 14, wv_); gsync((unsigned*)(PP().ws + O_BAR) + 32, (unsigned)(2 * 14 + 2) * gridDim.x, wv_); }
#endif
#if DBG
  { CP& p = PP(); const unsigned f = __hip_atomic_load((unsigned*)(p.ws + O_BAR) + 16, __ATOMIC_RELAXED, __HIP_MEMORY_SCOPE_AGENT);
    if (f) { float val = 1000.f * (float)(32u - f);
      if (32u - f == 6u) { const unsigned* fw = (const unsigned*)(p.ws + O_BAR) + 17; float dg[3];
        for (int q = 0; q < 3; ++q) { const unsigned w = __hip_atomic_load(fw + q, __ATOMIC_RELAXED, __HIP_MEMORY_SCOPE_AGENT); const int c = w ? 1000 - (int)w : -1;
          dg[q] = c < 0 ? 0.f : (c < 4 ? 1.f : (c < 8 ? 2.f : (c < 16 ? 3.f : (c < 32 ? 4.f : (c < 64 ? 5.f : (c < 128 ? 6.f : 7.f)))))); }
        val = 1000.f + 100.f * ((dg[0] > 0.f ? 4.f : 0.f) + (dg[1] > 0.f ? 2.f : 0.f) + (dg[2] > 0.f ? 1.f : 0.f));
        for (size_t i = (size_t)blockIdx.x * 512 + TIDX; i < NLAT * 2048; i += (size_t)gridDim.x * 512) p.out[i] = val; return; } for (size_t i = (size_t)blockIdx.x * 512 + TIDX; i < NLAT * 2048; i += (size_t)gridDim.x * 512) p.out[i] = val; } }
#endif
}

extern "C" void kernel_launch(void* const* d_in, const int* in_sizes, int n_in, void* d_out, int out_size, void* d_ws, size_t ws_size, hipStream_t stream) {
  static int grid = 0;
  if (grid == 0) {
    if (n_in != 25 || out_size != 32768 * 2048 || ws_size < O_END) { fprintf(stderr, "kernel_launch: unexpected shapes (n_in %d out %d ws %zu need %zu)\n", n_in, out_size, ws_size, (size_t)O_END); grid = -1; return; }
    int dev = 0, cus = 0, per_cu = 0;
    hipGetDevice(&dev); hipDeviceGetAttribute(&cus, hipDeviceAttributeMultiprocessorCount, dev);
    if (hipFuncSetAttribute((const void*)mega, hipFuncAttributeMaxDynamicSharedMemorySize, LDS_BYTES) != hipSuccess) { fprintf(stderr, "kernel_launch: hipFuncSetAttribute failed\n"); grid = -1; return; }
    if (hipOccupancyMaxActiveBlocksPerMultiprocessor(&per_cu, (const void*)mega, 512, LDS_BYTES) != hipSuccess || per_cu < 1) { fprintf(stderr, "kernel_launch: occupancy query says %d\n", per_cu); per_cu = 1; }
    (void)hipGetLastError();
    grid = cus;
  }
  if (grid < 0) return;
  (void)hipMemsetAsync((char*)d_ws + O_MOD, 0, 3 * 12288 * 4 + 16384, stream);
  P p{};
  for (int i = 0; i < 25; ++i) p.in[i] = (const float*)d_in[i];
  p.out = (float*)d_out; p.ws = (char*)d_ws;
#if N_LAUNCH_PER_PHASE
  for (int ph = 0; ph < NPHASE; ++ph) { int lo = ph, hi = ph; void* args[] = {&p, &lo, &hi};
    hipLaunchCooperativeKernel((const void*)mega, dim3(grid), dim3(512), args, LDS_BYTES, stream); }
#else
  int lo = 0, hi = NPHASE - 1; void* args[] = {&p, &lo, &hi};
  hipError_t e = hipLaunchCooperativeKernel((const void*)mega, dim3(grid), dim3(512), args, LDS_BYTES, stream);
  if (e != hipSuccess) fprintf(stderr, "cooperative launch failed: %s (grid %d)\n", hipGetErrorString(e), grid);
#endif
}
```

```cpp
#include <hip/hip_runtime.h>
#include <hip/hip_cooperative_groups.h>
#include <cstdio>
#include <cstdint>
namespace cg = cooperative_groups;

#ifndef DBG
#define DBG 0
#endif
#ifndef REP
#define REP -1
#endif
#ifndef N_LAUNCH_PER_PHASE
#define N_LAUNCH_PER_PHASE 0
#endif

#define LAS __attribute__((address_space(3)))
typedef unsigned short bf16_t;
typedef short bf16x8 __attribute__((ext_vector_type(8)));
typedef short s16x4 __attribute__((ext_vector_type(4)));
typedef float f32x4 __attribute__((ext_vector_type(4)));
typedef float f32x16 __attribute__((ext_vector_type(16)));
typedef unsigned u32x4 __attribute__((ext_vector_type(4)));
typedef unsigned u32x2 __attribute__((ext_vector_type(2)));

constexpr float EPS = 1e-6f;
constexpr size_t NROW = 33280, NLAT = 32768;
constexpr int LDS_BYTES = 143360;
constexpr int NPHASE = 15;

constexpr size_t O_MOD  = 0;
constexpr size_t O_BAR  = 147456;
constexpr size_t O_WIN  = 262144;
constexpr size_t O_WQB  = O_WIN  + 9472ull * 2048 * 2;
constexpr size_t O_WKVB = O_WQB  + 1536ull * 512 * 2;
constexpr size_t O_WCAT = O_WKVB + 2048ull * 512 * 2;
constexpr size_t O_WOUT = O_WCAT + 2048ull * 2048 * 2;
constexpr size_t O_WUP  = O_WOUT + 2048ull * 2048 * 2;
constexpr size_t O_WDN  = O_WUP  + 11008ull * 2048 * 2;
constexpr size_t O_XN   = O_WDN  + 2048ull * 5504 * 2;
constexpr size_t O_QN   = O_XN;
constexpr size_t O_KN   = O_XN + NROW * 1024 * 2;
constexpr size_t O_QKVA = O_XN + NROW * 2048 * 2;
constexpr size_t O_ACH  = O_QKVA + NROW * 1024 * 2;
constexpr size_t O_DQKV = O_ACH + NROW * 1024 * 2;
constexpr size_t O_VN   = O_DQKV + NROW * 3072 * 2;
constexpr size_t O_ZG   = O_VN + NROW * 1024 * 2;
constexpr size_t O_MISC = O_ZG + NROW * 5120 * 2;
constexpr size_t O_G    = O_MISC + NROW * 96 * 4;
constexpr size_t O_BETA = O_G + 2ull * 2 * 8 * 16640 * 4;
constexpr size_t O_GC   = O_BETA + 2ull * 2 * 8 * 16640 * 4;
constexpr size_t O_RSTD = O_GC + 2ull * 2 * 8 * 16640 * 4;
constexpr size_t O_UC   = O_RSTD + NROW * 2 * 4;
constexpr size_t O_WC   = O_UC + 2ull * 2 * 256 * 1024 * 2;
constexpr size_t O_END  = O_WC + 2ull * 2 * 256 * 1024 * 2;
constexpr size_t O_OSC   = O_DQKV;
constexpr size_t O_KVRAW = O_OSC + 2ull * 32768 * 1024 * 2;
constexpr size_t O_Q = O_XN + 1572864;
constexpr size_t O_K = O_Q + 2ull * 8 * 16384 * 192 * 2;
constexpr size_t O_V = O_K + 2ull * 8 * 16640 * 192 * 2;
constexpr size_t O_MERGED = O_DQKV;
constexpr size_t O_XN2 = O_XN;
constexpr size_t O_H = O_QKVA;
constexpr size_t O_SIDE = O_H + NLAT * 5504 * 2;
static_assert(O_KVRAW + NROW * 2048 * 2 <= O_ZG, "raw overlay");
static_assert(O_V + 2ull * 8 * 16640 * 128 * 2 <= O_DQKV && O_V >= O_ACH, "qkv overlay");
static_assert(O_SIDE + 2ull * 512 * 3 * 5504 * 4 <= O_END, "h overlay");
constexpr size_t DO_YCAT = 2ull * 32768 * 1024 * 2;

struct P { const float* in[25]; float* out; char* ws; };
typedef const __attribute__((address_space(4))) P CP;
enum { I_X = 0, I_C, I_CTX, I_CCTX, I_WADA, I_BADA, I_NMIX, I_WIN, I_QAN, I_WQB, I_KVAN, I_WKVB, I_QN, I_KNORM, I_WOMLA, I_DNCONV, I_ALOG, I_DTB, I_ONORM, I_WODN, I_WOUT, I_NFFN, I_WUP, I_FCONV, I_WDOWN };

__device__ __forceinline__ int lane_id_v() { int r; asm volatile("v_mbcnt_lo_u32_b32 %0, -1, 0\n\tv_mbcnt_hi_u32_b32 %0, -1, %0" : "=v"(r)); return r; }
#define TIDX (wv_ * 64 + lane_id_v())
typedef __bf16 bf16v2_t __attribute__((ext_vector_type(2)));
typedef float f32v2_t __attribute__((ext_vector_type(2)));
__device__ __forceinline__ unsigned cvtpk(float lo, float hi) { const f32v2_t v = {lo, hi}; const bf16v2_t r = __builtin_convertvector(v, bf16v2_t); return __builtin_bit_cast(unsigned, r); }
__device__ __forceinline__ float bflo(unsigned w) { return __uint_as_float(w << 16); }
__device__ __forceinline__ float bfhi(unsigned w) { return __uint_as_float(w & 0xffff0000u); }
__device__ __forceinline__ float bf2f(bf16_t v) { return __uint_as_float(((unsigned)v) << 16); }
__device__ __forceinline__ bf16_t f2bf(float f) { return (bf16_t)(cvtpk(f, 0.f) & 0xffffu); }
__device__ __forceinline__ float silu_f(float x) { return x * __builtin_amdgcn_rcpf(1.f + __expf(-x)); }
__device__ __forceinline__ float sigmoid_f(float x) { return __builtin_amdgcn_rcpf(1.f + __expf(-x)); }
__device__ __forceinline__ void unpack8(u32x4 w, float* f) { f[0] = bflo(w.x); f[1] = bfhi(w.x); f[2] = bflo(w.y); f[3] = bfhi(w.y); f[4] = bflo(w.z); f[5] = bfhi(w.z); f[6] = bflo(w.w); f[7] = bfhi(w.w); }
__device__ __forceinline__ u32x4 pack8(const float* f) { u32x4 w; w.x = cvtpk(f[0], f[1]); w.y = cvtpk(f[2], f[3]); w.z = cvtpk(f[4], f[5]); w.w = cvtpk(f[6], f[7]); return w; }

__device__ __forceinline__ int dn_row(int dir, int b, int s) {
  if (s < 256) { const int j = dir ? 255 - s : s; return 32768 + b * 256 + j; }
  int t = s - 256; if (dir) t = 16383 - t; return b * 16384 + t;
}
__device__ __forceinline__ bf16_t* uw_ptr(CP& p, int which, int dir, int b, int s) {
  if (s < 256) return (bf16_t*)(p.ws + (which ? O_WC : O_UC)) + ((size_t)((dir * 2 + b) * 256 + s)) * 1024;
  return (bf16_t*)p.out + ((size_t)((which * 2 + dir) * 2 + b) * 16384 + (size_t)(s - 256)) * 1024;
}

namespace gm {
constexpr int BM = 256, BK = 64, HALF = 128, HTB = HALF * BK * 2, NXCD = 8, WGM = 8;
__device__ __forceinline__ int lds_byte(int r, int c) { const int st = (r >> 4) * 2 + (c >> 5), rr = r & 15, cc = c & 31, ob = rr * 64 + cc * 2; return st * 1024 + (ob ^ (((ob >> 9) & 1) << 5)); }
__device__ __forceinline__ int perm32(int rho) { const int n = rho >> 4, i = rho & 15; return 8 * (i >> 2) + 4 * n + (i & 3); }
__device__ __forceinline__ void stage_rc(int b, int& R, int& C) { const int st = b / 1024, sb = b % 1024, swz = sb ^ (((sb >> 9) & 1) << 5); R = (st >> 1) * 16 + swz / 64; C = (st & 1) * 32 + (swz % 64) / 2; }
struct Unit { int pm, pn, seg; };
__device__ __forceinline__ bool tile_order(int i, int nM, int nN, int& pm, int& pn) {
  const int nwg = nM * nN; const long L = (long)i * gridDim.x + blockIdx.x; if (L >= nwg) return false;
  int wgid = (int)L; { const int q = nwg / NXCD, r = nwg % NXCD, xcd = wgid % NXCD, off = wgid / NXCD; wgid = (xcd < r ? xcd * (q + 1) : r * (q + 1) + (xcd - r) * q) + off; }
  const int nig = WGM * nN, gid = wgid / nig, fm = gid * WGM, gsz = (nM - fm) < WGM ? (nM - fm) : WGM;
  pm = fm + ((wgid % nig) % gsz); pn = (wgid % nig) / gsz; return true;
}

template <class Job>
__device__ __forceinline__ void gemm_phase(LAS unsigned char* lds, const Job& J, int wv_) {
  const int tid = TIDX, wid = __builtin_amdgcn_readfirstlane(tid >> 6), lane = tid & 63, wr = wid >> 2, wc = wid & 3, fr = lane & 15, fq = lane >> 4;
  const int K = J.K, nt = K / BK; const long lda = J.lda, ldb = J.ldb;
  unsigned voffA[2], voffB[2];
#pragma unroll
  for (int i = 0; i < 2; ++i) { int R, C; stage_rc(tid * 16 + i * 8192, R, C); const int Rb = (R & ~31) + perm32(R & 31); voffA[i] = (unsigned)(R * lda + C) * 2u; voffB[i] = (unsigned)(Rb * ldb + C) * 2u; }
  const size_t kstep = (size_t)(BK * 2);
  const size_t hstepA = (size_t)HALF * lda * 2, hstepB = (size_t)HALF * ldb * 2;
  const unsigned ldsw = (unsigned)wid * 1024u;
  const int aoff = lds_byte(wr * 64 + fr, fq * 8), boff = lds_byte(wc * 32 + fr, fq * 8);
#define G_SA(b, h) (((b) * 2 + (h)) * HTB)
#define G_SB(b, h) ((4 + (b) * 2 + (h)) * HTB)
#define G_STAGE(bufoff, gbase, voff) do { _Pragma("unroll") for (int _i = 0; _i < 2; ++_i) \
    __builtin_amdgcn_global_load_lds((const unsigned*)((const char*)(gbase) + (voff)[_i]), (LAS unsigned*)(lds + (bufoff) + ldsw + _i * 8192), 16, 0, 0); } while (0)
#define G_LDA(dst, b, h) do { _Pragma("unroll") for (int m = 0; m < 4; ++m) _Pragma("unroll") for (int k = 0; k < 2; ++k) dst[m][k] = *(const LAS bf16x8*)(lds + G_SA(b, h) + aoff + m * 2048 + k * 1024); } while (0)
#define G_LDB(dst, b, h) do { _Pragma("unroll") for (int n = 0; n < 2; ++n) _Pragma("unroll") for (int k = 0; k < 2; ++k) dst[n][k] = *(const LAS bf16x8*)(lds + G_SB(b, h) + boff + n * 2048 + k * 1024); } while (0)
#define G_MMA(ai, bj, At, Bt) do { __builtin_amdgcn_s_setprio(1); _Pragma("unroll") for (int m = 0; m < 4; ++m) _Pragma("unroll") for (int n = 0; n < 2; ++n) _Pragma("unroll") for (int k = 0; k < 2; ++k) \
    acc[ai][bj][m][n] = __builtin_amdgcn_mfma_f32_16x16x32_bf16(Bt[n][k], At[m][k], acc[ai][bj][m][n], 0, 0, 0); __builtin_amdgcn_s_setprio(0); } while (0)
#define G_WAIT_V(n) asm volatile("s_waitcnt vmcnt(" #n ")" ::: "memory")
#define G_WAIT_L(n) asm volatile("s_waitcnt lgkmcnt(" #n ")" ::: "memory")
#define G_BAR __builtin_amdgcn_s_barrier()
#define G_SCHED __builtin_amdgcn_sched_barrier(0)
#define G_ZERO() do { _Pragma("unroll") for (int a = 0; a < 2; ++a) _Pragma("unroll") for (int b = 0; b < 2; ++b) _Pragma("unroll") for (int m = 0; m < 4; ++m) _Pragma("unroll") for (int n = 0; n < 2; ++n) acc[a][b][m][n] = (f32x4){0.f, 0.f, 0.f, 0.f}; } while (0)
  Unit cur, nxt; int ui = 0;
  if (!J.next(0, cur)) return;
  f32x4 acc[2][2][4][2];
  G_ZERO();
  bf16x8 At[4][2], B0[2][2], B1[2][2];
  const char* cA = J.aptr(cur); const char* cB = J.bptr(cur);
  G_STAGE(G_SB(0, 0), cB, voffB); G_STAGE(G_SB(0, 1), cB + hstepB, voffB); G_STAGE(G_SA(0, 0), cA, voffA); G_STAGE(G_SA(0, 1), cA + hstepA, voffA);
  if (wr == 1) G_BAR;
  G_WAIT_V(2); G_BAR;
  G_STAGE(G_SB(1, 0), cB + kstep, voffB); G_STAGE(G_SA(1, 0), cA + kstep, voffA); G_STAGE(G_SB(1, 1), cB + hstepB + kstep, voffB);
  G_WAIT_V(6); G_BAR;
  for (;;) {
    const bool has_next = J.next(ui + 1, nxt);
    const char* nA = has_next ? J.aptr(nxt) : cA; const char* nB = has_next ? J.bptr(nxt) : cB;
    for (int t = 0; t < nt; t += 2) {
      const bool last = (t == nt - 2);
      const char* a1 = cA + (size_t)(t + 1) * kstep;
      const char* a2 = last ? nA : cA + (size_t)(t + 2) * kstep; const char* b2 = last ? nB : cB + (size_t)(t + 2) * kstep;
      const char* a3 = a2 + kstep; const char* b3 = b2 + kstep;
      G_LDB(B0, 0, 0); G_LDB(B1, 0, 1); G_SCHED; G_LDA(At, 0, 0); G_STAGE(G_SA(1, 1), a1 + hstepA, voffA);
      G_WAIT_V(8); G_WAIT_L(0); G_BAR; G_MMA(0, 0, At, B0); G_MMA(0, 1, At, B1); G_BAR; G_SCHED;
      G_LDA(At, 0, 1); G_STAGE(G_SB(0, 0), b2, voffB); G_STAGE(G_SB(0, 1), b2 + hstepB, voffB); G_STAGE(G_SA(0, 0), a2, voffA);
      G_WAIT_V(8); G_WAIT_L(0); G_BAR; G_MMA(1, 0, At, B0); G_MMA(1, 1, At, B1); G_BAR; G_SCHED;
      G_LDB(B0, 1, 0); G_LDB(B1, 1, 1); G_SCHED; G_LDA(At, 1, 0); G_STAGE(G_SA(0, 1), a2 + hstepA, voffA);
      G_WAIT_V(8); G_WAIT_L(0); G_BAR; G_MMA(0, 0, At, B0); G_MMA(0, 1, At, B1); G_BAR; G_SCHED;
      G_LDA(At, 1, 1); G_STAGE(G_SB(1, 0), b3, voffB); G_STAGE(G_SB(1, 1), b3 + hstepB, voffB); G_STAGE(G_SA(1, 0), a3, voffA);
      G_WAIT_V(8); G_WAIT_L(0); G_BAR; G_MMA(1, 0, At, B0); G_MMA(1, 1, At, B1); G_BAR; G_SCHED;
    }
    if (wr == 0) G_BAR;
    const bool z = J.epi(acc, cur, wr, wc, fr, fq);
    if (!has_next) break;
    if (z) G_ZERO();
    cur = nxt; cA = nA; cB = nB; ++ui;
    if (wr == 1) G_BAR;
  }
  G_WAIT_V(0);
  G_BAR;
#undef G_SA
#undef G_SB
#undef G_STAGE
#undef G_LDA
#undef G_LDB
#undef G_MMA
#undef G_ZERO
}

#define EPI_FOR(u) _Pragma("unroll") for (int ai = 0; ai < 2; ++ai) _Pragma("unroll") for (int m = 0; m < 4; ++m) _Pragma("unroll") for (int bj = 0; bj < 2; ++bj)
#define EPI_ROW(u) ((u).pm * 256 + ai * 128 + wr * 64 + m * 16 + fr)
#define EPI_COL(u) ((u).pn * 256 + bj * 128 + wc * 32 + fq * 8)
__device__ __forceinline__ void st_bf4(bf16_t* p, f32x4 v) { u32x2 w; w.x = cvtpk(v[0], v[1]); w.y = cvtpk(v[2], v[3]); *(u32x2*)p = w; }
__device__ __forceinline__ void st_bf8(bf16_t* p, f32x4 v0, f32x4 v1) { u32x4 w; w.x = cvtpk(v0[0], v0[1]); w.y = cvtpk(v0[2], v0[3]); w.z = cvtpk(v1[0], v1[1]); w.w = cvtpk(v1[2], v1[3]); *(u32x4*)p = w; }

struct JobBase {
  const char* A; const char* B; int K, lda, ldb, nM, nN;
  __device__ __forceinline__ bool next(int i, Unit& u) const {
    if (!tile_order(i, nM, nN, u.pm, u.pn)) return false;
    u.seg = 0; return true;
  }
  __device__ __forceinline__ const char* aptr(const Unit& u) const { return A + (size_t)u.pm * 256 * lda * 2; }
  __device__ __forceinline__ const char* bptr(const Unit& u) const { return B + (size_t)u.pn * 256 * ldb * 2; }
};
struct JobInproj : JobBase {
  char* ws;
  __device__ __forceinline__ bool epi(f32x4 (&acc)[2][2][4][2], const Unit& u, int wr, int wc, int fr, int fq) const {
    if (u.pn < 36) {
      bf16_t* base; int ldc, c0;
      if (u.pn < 4) { base = (bf16_t*)(ws + O_QKVA); ldc = 1024; c0 = u.pn * 256; }
      else if (u.pn < 16) { base = (bf16_t*)(ws + O_DQKV); ldc = 3072; c0 = (u.pn - 4) * 256; }
      else { base = (bf16_t*)(ws + O_ZG); ldc = 5120; c0 = (u.pn - 16) * 256; }
      EPI_FOR(u) { const int row = EPI_ROW(u), col = c0 + bj * 128 + wc * 32 + fq * 8; st_bf8(base + (size_t)row * ldc + col, acc[ai][bj][m][0], acc[ai][bj][m][1]); }
    } else {
      float* base = (float*)(ws + O_MISC);
      EPI_FOR(u) { const int row = EPI_ROW(u), col = bj * 128 + wc * 32 + fq * 8; if (col < 96) { *(f32x4*)(base + (size_t)row * 96 + col) = acc[ai][bj][m][0]; *(f32x4*)(base + (size_t)row * 96 + col + 4) = acc[ai][bj][m][1]; } }
    }
    return true;
  }
};
struct JobPlain : JobBase {
  bf16_t* O; int ldc;
  __device__ __forceinline__ bool epi(f32x4 (&acc)[2][2][4][2], const Unit& u, int wr, int wc, int fr, int fq) const {
    EPI_FOR(u) { const int row = EPI_ROW(u), col = EPI_COL(u); st_bf8(O + (size_t)row * ldc + col, acc[ai][bj][m][0], acc[ai][bj][m][1]); }
    return true;
  }
};
struct JobKV : JobBase {
  bf16_t* O; bf16_t* V; const float* rstd;
  __device__ __forceinline__ bool epi(f32x4 (&acc)[2][2][4][2], const Unit& u, int wr, int wc, int fr, int fq) const {
#pragma unroll
    for (int ai = 0; ai < 2; ++ai)
#pragma unroll
      for (int m = 0; m < 4; ++m) { const int row = u.pm * 256 + ai * 128 + wr * 64 + m * 16 + fr, c8 = wc * 32 + fq * 8;
        st_bf8(O + (size_t)row * 2048 + u.pn * 256 + c8, acc[ai][0][m][0], acc[ai][0][m][1]);
        int b, pos; if (row < 32768) { b = row >> 14; pos = row & 16383; } else { b = (row - 32768) >> 8; pos = 16384 + ((row - 32768) & 255); }
        const float rs = rstd[row * 2 + 1];
        st_bf8(V + ((size_t)(b * 8 + u.pn) * 16640 + pos) * 128 + c8, acc[ai][1][m][0] * rs, acc[ai][1][m][1] * rs); }
    return true;
  }
};
struct JobMerge : JobBase {
  const bf16_t* ZG; bf16_t* O;
  __device__ __forceinline__ bool next(int i, Unit& u) const {
    if (!tile_order(i >> 1, nM, nN, u.pm, u.pn)) return false;
    u.seg = i & 1; return true;
  }
  __device__ __forceinline__ const char* aptr(const Unit& u) const { return A + (size_t)u.pm * 256 * lda * 2 + (size_t)u.seg * 2048; }
  __device__ __forceinline__ const char* bptr(const Unit& u) const { return B + (size_t)u.pn * 256 * ldb * 2 + (size_t)u.seg * 2048; }
  __device__ __forceinline__ bool epi(f32x4 (&acc)[2][2][4][2], const Unit& u, int wr, int wc, int fr, int fq) const {
    if (u.seg == 0) {
      EPI_FOR(u) { const int row = EPI_ROW(u), col = EPI_COL(u); const bf16_t* z = ZG + (size_t)row * 5120 + col;
        float ga[8], gb[8]; unpack8(*(const u32x4*)(z + 1024), ga); unpack8(*(const u32x4*)(z + 3072), gb);
#pragma unroll
        for (int e = 0; e < 8; ++e) acc[ai][bj][m][e >> 2][e & 3] *= (1.f + __expf(-gb[e])) * __builtin_amdgcn_rcpf(1.f + __expf(-ga[e])); }
      return false;
    }
    EPI_FOR(u) { const int row = EPI_ROW(u), col = EPI_COL(u); const bf16_t* z = ZG + (size_t)row * 5120 + col;
      float gb[8]; unpack8(*(const u32x4*)(z + 3072), gb);
      f32x4 v0 = acc[ai][bj][m][0], v1 = acc[ai][bj][m][1];
#pragma unroll
      for (int e = 0; e < 4; ++e) { v0[e] *= sigmoid_f(gb[e]); v1[e] *= sigmoid_f(gb[4 + e]); }
      st_bf8(O + (size_t)row * 2048 + col, v0, v1); }
    return true;
  }
};
struct JobUpGlu : JobBase {
  bf16_t* O; const float* cw; float* side;
  __device__ __forceinline__ bool epi(f32x4 (&acc)[2][2][4][2], const Unit& u, int wr, int wc, int fr, int fq) const {
    const int c8 = u.pn * 128 + wc * 32 + fq * 8; const int lane = fq * 16 + fr;
    const int lp = (lane & 48) | ((fr + 15) & 15), ln = (lane & 48) | ((fr + 1) & 15);
    float w0[8], w1[8], w2[8];
    { const f32x4 a = *(const f32x4*)(cw + c8), b = *(const f32x4*)(cw + c8 + 4), c = *(const f32x4*)(cw + 5504 + c8), d = *(const f32x4*)(cw + 5504 + c8 + 4), e = *(const f32x4*)(cw + 11008 + c8), f = *(const f32x4*)(cw + 11008 + c8 + 4);
#pragma unroll
      for (int q = 0; q < 4; ++q) { w0[q] = a[q]; w0[4 + q] = b[q]; w1[q] = c[q]; w1[4 + q] = d[q]; w2[q] = e[q]; w2[4 + q] = f[q]; } }
#pragma unroll
    for (int ai = 0; ai < 2; ++ai) {
      const int rbase = u.pm * 256 + ai * 128 + wr * 64, rb = rbase >> 6;
      float ov[4][8];
#pragma unroll
      for (int s = 0; s < 8; ++s) {
        float g[4], rp[4], rn[4];
#pragma unroll
        for (int m = 0; m < 4; ++m) { g[m] = acc[ai][0][m][s >> 2][s & 3]; rp[m] = __shfl(g[m], lp); rn[m] = __shfl(g[m], ln); }
#pragma unroll
        for (int m = 0; m < 4; ++m) {
          const float pv = fr == 0 ? (m > 0 ? rp[m > 0 ? m - 1 : 0] : 0.f) : rp[m];
          const float nv = fr == 15 ? (m < 3 ? rn[m < 3 ? m + 1 : 3] : 0.f) : rn[m];
          const float cv = w0[s] * pv + w1[s] * g[m] + w2[s] * nv, vv = acc[ai][1][m][s >> 2][s & 3];
          ov[m][s] = silu_f(cv) * vv;
          if (m == 0 && fr == 0) { float* sp = side + ((size_t)(0 * 512 + rb) * 3) * 5504 + c8 + s; sp[0] = cv; sp[5504] = vv; sp[2 * 5504] = g[m]; }
          if (m == 3 && fr == 15) { float* sp = side + ((size_t)(1 * 512 + rb) * 3) * 5504 + c8 + s; sp[0] = cv; sp[5504] = vv; sp[2 * 5504] = g[m]; }
        }
      }
#pragma unroll
      for (int m = 0; m < 4; ++m) *(u32x4*)(O + (size_t)(rbase + m * 16 + fr) * 5504 + c8) = pack8(ov[m]);
    }
    return true;
  }
};
struct JobResid : JobBase {
  const float* base; const float* gate; float* out;
  __device__ __forceinline__ bool epi(f32x4 (&acc)[2][2][4][2], const Unit& u, int wr, int wc, int fr, int fq) const {
    EPI_FOR(u) { const int row = EPI_ROW(u), col = EPI_COL(u);
      const float* gp = gate + (size_t)(row >> 14) * 12288 + col; const float* xp = base + (size_t)row * 2048 + col; float* op = out + (size_t)row * 2048 + col;
      const f32x4 g0 = *(const f32x4*)gp, g1 = *(const f32x4*)(gp + 4), x0 = *(const f32x4*)xp, x1 = *(const f32x4*)(xp + 4);
      *(f32x4*)op = x0 + g0 * acc[ai][bj][m][0]; *(f32x4*)(op + 4) = x1 + g1 * acc[ai][bj][m][1]; }
    return true;
  }
};
}

__device__ __forceinline__ int win_srccol(int n) {
  if (n < 1024) return n; if (n < 5120) return n + 64; if (n < 9216) return n + 96;
  if (n < 9280) return 1024 + (n - 9216); if (n < 9296) return 5184 + (n - 9280); if (n < 9312) return 5200 + (n - 9296); return -1;
}
__device__ __forceinline__ void transpose_tile(int wv_, const float* __restrict__ src, int Nsrc, bf16_t* __restrict__ dst, int ldd, int k0, int n0, int mode, const float* __restrict__ kscale, float* tl) {
  const int tid = TIDX, n4 = (tid & 15) * 4, kk0 = tid >> 4;
  const int nd_ = n0 + n4;
  const int sc = mode == 1 ? win_srccol(nd_) : (mode == 2 ? ((nd_ >> 7) & 1) * 5504 + (nd_ >> 8) * 128 + (nd_ & 127) : nd_);
#pragma unroll
  for (int i = 0; i < 2; ++i) { const int kk = kk0 + 32 * i;
    f32x4 v = sc >= 0 ? *(const f32x4*)(src + (size_t)(k0 + kk) * Nsrc + sc) : (f32x4){0.f, 0.f, 0.f, 0.f};
    if (kscale) v *= kscale[k0 + kk];
    tl[kk * 65 + n4] = v[0]; tl[kk * 65 + n4 + 1] = v[1]; tl[kk * 65 + n4 + 2] = v[2]; tl[kk * 65 + n4 + 3] = v[3]; }
  __syncthreads();
  { const int n2 = tid >> 3, kc = tid & 7; float f[8];
#pragma unroll
    for (int j = 0; j < 8; ++j) f[j] = tl[(kc * 8 + j) * 65 + n2];
    *(u32x4*)(dst + (size_t)(n0 + n2) * ldd + k0 + kc * 8) = pack8(f); }
  __syncthreads();
}
__device__ __forceinline__ void phase_prep(CP& p, char* lds, int wv_, int it0 = 0) {
  float* tl = (float*)lds; const int tid = TIDX;
  constexpr int NADA = 384;
  constexpr int T1 = 32 * 148, T2 = T1 + 8 * 24, T3 = T2 + 8 * 32, T4 = T3 + 16 * 32, T5 = T4 + 16 * 32, T6 = T5 + 32 * 32, T7 = T6 + 32 * 172, T8 = T7 + 86 * 32;
  for (int it = it0 + blockIdx.x; it < NADA + T8; it += gridDim.x) {
    if (it < NADA) {
      const int cgp = it % 6, kc = it / 6, col = cgp * 2048 + tid * 4;
      if (tid < 96) { const int r = tid >> 5, k = kc * 32 + (tid & 31); const float cv = r < 2 ? p.in[I_C][r * 2048 + k] : p.in[I_CCTX][k]; tl[tid] = silu_f(cv); }
      __syncthreads();
      f32x4 a0 = {0, 0, 0, 0}, a1 = a0, a2 = a0;
      const float* w = p.in[I_WADA] + (size_t)(kc * 32) * 12288 + col;
#pragma unroll 8
      for (int k = 0; k < 32; ++k) { const f32x4 wv = *(const f32x4*)(w + (size_t)k * 12288); a0 += tl[k] * wv; a1 += tl[32 + k] * wv; a2 += tl[64 + k] * wv; }
      if (kc == 0) { const f32x4 bv = *(const f32x4*)(p.in[I_BADA] + col); a0 += bv; a1 += bv; a2 += bv; }
      float* mod = (float*)(p.ws + O_MOD);
#pragma unroll
      for (int e = 0; e < 4; ++e) { atomicAdd(mod + col + e, a0[e]); atomicAdd(mod + 12288 + col + e, a1[e]); atomicAdd(mod + 2 * 12288 + col + e, a2[e]); }
      __syncthreads();
    } else {
      int t = it - NADA;
      if (t < T1) { transpose_tile(wv_, p.in[I_WIN], 9312, (bf16_t*)(p.ws + O_WIN), 2048, (t % 32) * 64, (t / 32) * 64, 1, nullptr, tl); }
      else if (t < T2) { t -= T1; transpose_tile(wv_, p.in[I_WQB], 1536, (bf16_t*)(p.ws + O_WQB), 512, (t % 8) * 64, (t / 8) * 64, 0, p.in[I_QAN], tl); }
      else if (t < T3) { t -= T2; transpose_tile(wv_, p.in[I_WKVB], 2048, (bf16_t*)(p.ws + O_WKVB), 512, (t % 8) * 64, (t / 8) * 64, 0, p.in[I_KVAN], tl); }
      else if (t < T4) { t -= T3; transpose_tile(wv_, p.in[I_WOMLA], 2048, (bf16_t*)(p.ws + O_WCAT), 2048, (t % 16) * 64, (t / 16) * 64, 0, nullptr, tl); }
      else if (t < T5) { t -= T4; transpose_tile(wv_, p.in[I_WODN], 2048, (bf16_t*)(p.ws + O_WCAT) + 1024, 2048, (t % 16) * 64, (t / 16) * 64, 0, nullptr, tl); }
      else if (t < T6) { t -= T5; transpose_tile(wv_, p.in[I_WOUT], 2048, (bf16_t*)(p.ws + O_WOUT), 2048, (t % 32) * 64, (t / 32) * 64, 0, nullptr, tl); }
      else if (t < T7) { t -= T6; transpose_tile(wv_, p.in[I_WUP], 11008, (bf16_t*)(p.ws + O_WUP), 2048, (t % 32) * 64, (t / 32) * 64, 2, nullptr, tl); }
      else { t -= T7; transpose_tile(wv_, p.in[I_WDOWN], 2048, (bf16_t*)(p.ws + O_WDN), 5504, (t % 86) * 64, (t / 86) * 64, 0, nullptr, tl); }
    }
  }
}

template <int which> __device__ __forceinline__ void phase_normmod(CP& p, int wv_) {
  const int tid = TIDX, lane = tid & 63, gw = blockIdx.x * 8 + (tid >> 6), nw = gridDim.x * 8;
  const float* mod = (const float*)(p.ws + O_MOD);
  const int nrows = which ? 32768 : 33280;
  const float* wn = p.in[which ? I_NFFN : I_NMIX];
  bf16_t* dst = (bf16_t*)(p.ws + (which ? O_XN2 : O_XN));
  auto rowsrc = [&](int r) -> const float* {
    if (which) return p.out + (size_t)r * 2048;
    return r < 32768 ? p.in[I_X] + (size_t)r * 2048 : p.in[I_CTX] + (size_t)(r - 32768) * 2048; };
  f32x4 v[8];
  if (gw < nrows) { const float* src = rowsrc(gw);
#pragma unroll
    for (int j = 0; j < 8; ++j) v[j] = *(const f32x4*)(src + (j * 64 + lane) * 4); }
  for (int r = gw; r < nrows; r += nw) {
    f32x4 vn[8];
    { const float* src = rowsrc(min(r + nw, nrows - 1));
#pragma unroll
      for (int j = 0; j < 8; ++j) vn[j] = *(const f32x4*)(src + (j * 64 + lane) * 4); }
    const int mr = which ? (r >> 14) : (r < 32768 ? (r >> 14) : 2);
    const float* sh = mod + mr * 12288 + (which ? 3 : 0) * 2048; const float* sc = sh + 2048;
    float ss = 0.f;
#pragma unroll
    for (int j = 0; j < 8; ++j) ss += v[j][0] * v[j][0] + v[j][1] * v[j][1] + v[j][2] * v[j][2] + v[j][3] * v[j][3];
#pragma unroll
    for (int o = 1; o < 64; o <<= 1) ss += __shfl_xor(ss, o);
    const float rstd = rsqrtf(ss * (1.f / 2048.f) + EPS);
#pragma unroll
    for (int j = 0; j < 8; ++j) { const int c = (j * 64 + lane) * 4;
      const f32x4 w4 = *(const f32x4*)(wn + c), s4 = *(const f32x4*)(sc + c), h4 = *(const f32x4*)(sh + c);
      f32x4 y;
#pragma unroll
      for (int e = 0; e < 4; ++e) y[e] = (v[j][e] * rstd * w4[e]) * (1.f + s4[e]) + h4[e];
      gm::st_bf4(dst + (size_t)r * 2048 + c, y); }
#pragma unroll
    for (int j = 0; j < 8; ++j) v[j] = vn[j];
  }
}

__device__ __forceinline__ void phase_dnprep(CP& p, int wv_) {
  const int tid = TIDX, lane = tid & 63, gw = blockIdx.x * 8 + (tid >> 6), nw = gridDim.x * 8;
  const bf16_t* DQKV = (const bf16_t*)(p.ws + O_DQKV);
  {
    const int type = gw % 3, wsub = gw / 3, nsub = (nw - type + 2) / 3, c0 = lane * 16;
    float w0[16], w1[16], w2[16];
    { const float* cw = p.in[I_DNCONV] + type * 1024 + c0;
#pragma unroll
      for (int e = 0; e < 16; ++e) { w0[e] = cw[e]; w1[e] = cw[3072 + e]; w2[e] = cw[2 * 3072 + e]; } }
    bf16_t* dbase = (bf16_t*)(p.ws + (type == 0 ? O_QN : (type == 1 ? O_KN : O_VN))) + c0;
    const int nrows = type == 0 ? 32768 : 33280;
    for (int r0 = wsub; r0 < nrows; r0 += 4 * nsub) {
      u32x4 ld[4][6]; float mp[4], mn[4];
#pragma unroll
      for (int u = 0; u < 4; ++u) { const int r = min(r0 + u * nsub, nrows - 1); int pos, len;
        if (r < 32768) { pos = r & 16383; len = 16384; } else { pos = (r - 32768) & 255; len = 256; }
        mp[u] = pos > 0 ? 1.f : 0.f; mn[u] = pos < len - 1 ? 1.f : 0.f;
        const bf16_t* row = DQKV + (size_t)r * 3072 + type * 1024 + c0; const bf16_t* rp = pos > 0 ? row - 3072 : row; const bf16_t* rn = pos < len - 1 ? row + 3072 : row;
        ld[u][0] = *(const u32x4*)row; ld[u][1] = *(const u32x4*)(row + 8); ld[u][2] = *(const u32x4*)rp; ld[u][3] = *(const u32x4*)(rp + 8); ld[u][4] = *(const u32x4*)rn; ld[u][5] = *(const u32x4*)(rn + 8); }
#pragma unroll
      for (int u = 0; u < 4; ++u) { const int r = r0 + u * nsub; if (r >= nrows) break;
        float a[16], x[16];
        unpack8(ld[u][0], x); unpack8(ld[u][1], x + 8);
#pragma unroll
        for (int e = 0; e < 16; ++e) a[e] = w1[e] * x[e];
        unpack8(ld[u][2], x); unpack8(ld[u][3], x + 8);
#pragma unroll
        for (int e = 0; e < 16; ++e) a[e] += mp[u] * w0[e] * x[e];
        unpack8(ld[u][4], x); unpack8(ld[u][5], x + 8);
#pragma unroll
        for (int e = 0; e < 16; ++e) a[e] += mn[u] * w2[e] * x[e];
        float ss = 0.f;
#pragma unroll
        for (int e = 0; e < 16; ++e) { a[e] = silu_f(a[e]); ss += a[e] * a[e]; }
        if (type < 2) { ss += __shfl_xor(ss, 1); ss += __shfl_xor(ss, 2); ss += __shfl_xor(ss, 4);
          float sc = rsqrtf(ss + EPS); if (type == 0) sc *= 0.08838834764831845f;
#pragma unroll
          for (int e = 0; e < 16; ++e) a[e] *= sc; }
        bf16_t* dst = dbase + (size_t)r * 1024;
        *(u32x4*)dst = pack8(a); *(u32x4*)(dst + 8) = pack8(a + 8); }
    }
  }
  for (int r = gw; r < 33280; r += nw) {
    int b, pos; const bool isctx = r >= 32768;
    if (!isctx) { b = r >> 14; pos = r & 16383; } else { b = (r - 32768) >> 8; pos = (r - 32768) & 255; }
    const bf16_t* row = (const bf16_t*)(p.ws + O_QKVA) + (size_t)r * 1024 + lane * 16;
    float x[16]; { u32x4 q0 = *(const u32x4*)row, q1 = *(const u32x4*)(row + 8); unpack8(q0, x); unpack8(q1, x + 8); }
    float ss = 0.f;
#pragma unroll
    for (int e = 0; e < 16; ++e) ss += x[e] * x[e];
#pragma unroll
    for (int o = 1; o < 32; o <<= 1) ss += __shfl_xor(ss, o);
    if ((lane & 31) == 0) ((float*)(p.ws + O_RSTD))[r * 2 + (lane >> 5)] = rsqrtf(ss * (1.f / 512.f) + EPS);
    if (lane < 16) { const int dir = lane >> 3, h = lane & 7;
      const float* mi = (const float*)(p.ws + O_MISC) + (size_t)r * 96;
      const float da = mi[64 + lane] + p.in[I_DTB][lane], db = mi[80 + lane];
      const float sp = fmaxf(da, 0.f) + log1pf(__expf(-fabsf(da)));
      const float g = -__expf(p.in[I_ALOG][lane]) * sp;
      const int s_ = isctx ? (dir ? 255 - pos : pos) : 256 + (dir ? 16383 - pos : pos);
      const size_t o = (size_t)((dir * 2 + b) * 8 + h) * 16640 + s_;
      ((float*)(p.ws + O_G))[o] = g; ((float*)(p.ws + O_BETA))[o] = sigmoid_f(db); }
  }
}

__device__ __forceinline__ void phase_chunk(CP& p, char* lds, int wv_) {
  const int tid = TIDX, half = tid >> 8, t256 = tid & 255, w4 = (tid >> 6) & 3, lane = tid & 63, fr = lane & 15, fq = lane >> 4;
  char* hb = lds + half * 70400;
  bf16_t* kL = (bf16_t*)hb; bf16_t* qL = (bf16_t*)(hb + 17408); bf16_t* vL = (bf16_t*)(hb + 34816); float* Mm = (float*)(hb + 52224); float* gcL = (float*)(hb + 69632); float* beL = gcL + 64; float* bwL = gcL + 128;
  const bf16_t* QN = (const bf16_t*)(p.ws + O_QN); const bf16_t* KN = (const bf16_t*)(p.ws + O_KN); const bf16_t* VN = (const bf16_t*)(p.ws + O_VN);
  u32x4 pk_[4], pq_[4], pv_[4]; float pg_ = 0.f, pb_ = 0.f;
#define CH_LOAD(prx) do { const int idx_ = (prx) * 2 + half, c_ = idx_ % 260, grp_ = idx_ / 260, h_ = grp_ & 7, b_ = (grp_ >> 3) & 1, dir_ = grp_ >> 4, s0_ = c_ * 64; \
    _Pragma("unroll") for (int i = 0; i < 4; ++i) { const int id = t256 + 256 * i, rr = id >> 4, c8 = (id & 15) * 8; const size_t row = dn_row(dir_, b_, s0_ + rr); \
      pk_[i] = *(const u32x4*)(KN + row * 1024 + h_ * 128 + c8); pq_[i] = *(const u32x4*)(QN + row * 1024 + h_ * 128 + c8); pv_[i] = *(const u32x4*)(VN + row * 1024 + h_ * 128 + c8); } \
    if (t256 < 64) { const size_t go_ = (size_t)grp_ * 16640 + s0_; pg_ = ((const float*)(p.ws + O_G))[go_ + t256]; pb_ = ((const float*)(p.ws + O_BETA))[go_ + t256]; } } while (0)
  if ((int)blockIdx.x < 4160) CH_LOAD(blockIdx.x);
  for (int pr = blockIdx.x; pr < 4160; pr += gridDim.x) {
    const int idx = pr * 2 + half, c = idx % 260, grp = idx / 260, h = grp & 7, b = (grp >> 3) & 1, dir = grp >> 4, s0 = c * 64;
    const size_t go = (size_t)grp * 16640 + s0;
#pragma unroll
    for (int i = 0; i < 4; ++i) { const int id = t256 + 256 * i, rr = id >> 4, c8 = (id & 15) * 8;
      *(u32x4*)(kL + rr * 136 + c8) = pk_[i]; *(u32x4*)(qL + rr * 136 + c8) = pq_[i]; *(u32x4*)(vL + rr * 136 + c8) = pv_[i]; }
    if (t256 < 64) { float g = pg_;
#pragma unroll
      for (int o = 1; o < 64; o <<= 1) { const float n = __shfl_up(g, o); if (t256 >= o) g += n; }
      const float be_ = pb_; gcL[t256] = g; beL[t256] = be_; bwL[t256] = be_ * __expf(g); ((float*)(p.ws + O_GC))[go + t256] = g; }
    if (pr + (int)gridDim.x < 4160) CH_LOAD(pr + gridDim.x);
    __syncthreads();
    {
      bf16x8 ak[4], aq[4];
#pragma unroll
      for (int kk = 0; kk < 4; ++kk) { ak[kk] = *(const bf16x8*)(kL + (w4 * 16 + fr) * 136 + kk * 32 + fq * 8); aq[kk] = *(const bf16x8*)(qL + (w4 * 16 + fr) * 136 + kk * 32 + fq * 8); }
      bf16_t* Ag = (bf16_t*)(p.ws + O_ACH) + (size_t)idx * 4096;
#pragma unroll
      for (int jb = 0; jb < 4; ++jb) {
        f32x4 dk = {0, 0, 0, 0}, dq = {0, 0, 0, 0};
#pragma unroll
        for (int kk = 0; kk < 4; ++kk) { const bf16x8 bb = *(const bf16x8*)(kL + (jb * 16 + fr) * 136 + kk * 32 + fq * 8);
          dk = __builtin_amdgcn_mfma_f32_16x16x32_bf16(ak[kk], bb, dk, 0, 0, 0); dq = __builtin_amdgcn_mfma_f32_16x16x32_bf16(aq[kk], bb, dq, 0, 0, 0); }
        const int j = jb * 16 + fr; const float gj = gcL[j];
#pragma unroll
        for (int jj = 0; jj < 4; ++jj) { const int i = w4 * 16 + fq * 4 + jj; const float e = __expf(gcL[i] - gj);
          Mm[i * 68 + j] = (j < i) ? beL[i] * dk[jj] * e : 0.f;
          if (c >= 4) Ag[i * 64 + j] = f2bf((j <= i) ? dq[jj] * e : 0.f); }
      }
    }
    __syncthreads();
    {
      const int cc = t256 & 127; const bool isw = t256 >= 128;
      bf16_t* colp = (isw ? kL : vL) + cc; const float* fL = isw ? bwL : beL;
      f32v2_t xp[32];
#pragma unroll
      for (int i = 0; i < 64; ++i) {
        f32v2_t ra = {bf2f(colp[i * 136]) * fL[i], 0.f}, rb = {0.f, 0.f};
#pragma unroll
        for (int q = 0; q < i / 2; ++q) { const f32v2_t mp = *(const f32v2_t*)(Mm + i * 68 + 2 * q); if (q & 1) rb -= mp * xp[q]; else ra -= mp * xp[q]; }
        float r = (ra.x + ra.y) + (rb.x + rb.y);
        if (i & 1) r -= Mm[i * 68 + i - 1] * xp[i / 2].x;
        if (i & 1) xp[i / 2].y = r; else xp[i / 2].x = r;
        colp[i * 136] = f2bf(r);
        if ((i & 3) == 3) __builtin_amdgcn_sched_barrier(0);
      }
    }
    __syncthreads();
    { bf16_t* ub = uw_ptr(p, 0, dir, b, s0) + h * 128; bf16_t* wb = uw_ptr(p, 1, dir, b, s0) + h * 128;
#pragma unroll
      for (int i = 0; i < 4; ++i) { const int id = t256 + 256 * i, rr = id >> 4, c8 = (id & 15) * 8;
        *(u32x4*)(ub + (size_t)rr * 1024 + c8) = *(const u32x4*)(vL + rr * 136 + c8);
        *(u32x4*)(wb + (size_t)rr * 1024 + c8) = *(const u32x4*)(kL + rr * 136 + c8); } }
    __syncthreads();
  }
}

__device__ __forceinline__ void phase_scan(CP& p, char* lds, int wv_) {
  const int tid = TIDX, wid = tid >> 6, lane = tid & 63, fr = lane & 15, fq = lane >> 4;
  constexpr int WL = 0, QL = 17408, KT = 34816, AL = 53248, BUFSZ = 62464;
  bf16_t* ST = (bf16_t*)(lds + 2 * BUFSZ); bf16_t* VT = (bf16_t*)(lds + 2 * BUFSZ + 4352); bf16_t* VT2 = (bf16_t*)(lds + 2 * BUFSZ + 4352 + 2304);
  const int r0 = tid >> 4, c8 = (tid & 15) * 8, arow = tid >> 3, ac8 = (tid & 7) * 8;
  for (int item = blockIdx.x; item < 256; item += gridDim.x) {
    const int slice = item >> 5, grp = item & 31, h = grp & 7, b = (grp >> 3) & 1, dir = grp >> 4;
    const float* GCp = (const float*)(p.ws + O_GC) + (size_t)grp * 16640;
    const bf16_t* ACHp = (const bf16_t*)(p.ws + O_ACH) + (size_t)grp * 260 * 4096 + arow * 64 + ac8;
    const bf16_t* Wc = uw_ptr(p, 1, dir, b, 0); const bf16_t* Wl = uw_ptr(p, 1, dir, b, 256); const bf16_t* Uc = uw_ptr(p, 0, dir, b, 0); const bf16_t* Ul = uw_ptr(p, 0, dir, b, 256);
    const bf16_t* QNb = (const bf16_t*)(p.ws + O_QN); const bf16_t* KNb = (const bf16_t*)(p.ws + O_KN);
    const int woff = r0 * 1024 + h * 128 + c8;
    const int qkoff = (dir ? -r0 : r0) * 1024 + h * 128 + c8, qkstep = dir ? -32768 : 32768;
    const int uoff = ((wid & 3) * 16 + fq * 4) * 1024 + h * 128 + slice * 16 + fr;
    const int goff = (wid & 3) * 16 + fq * 4;
    u32x4 lw0, lw1, lq0, lq1, lk0, lk1, la0; f32x4 lg; float gl_r, gend_cur; float fac[4];
    bf16_t un[4] = {0, 0, 0, 0}; float uc[4];
#define SC_LOAD(c) do { const int c_ = (c); const bool ctx_ = c_ < 4; const int cc_ = ctx_ ? c_ : c_ - 4; \
      const bf16_t* wb_ = (ctx_ ? Wc : Wl) + (size_t)cc_ * 65536; const bf16_t* ub_ = (ctx_ ? Uc : Ul) + (size_t)cc_ * 65536; \
      const long row_ = ctx_ ? (32768 + b * 256 + (dir ? 255 - cc_ * 64 : cc_ * 64)) : (b * 16384 + (dir ? 16383 - cc_ * 64 : cc_ * 64)); \
      const bf16_t* qb_ = QNb + row_ * 1024; const bf16_t* kb_ = KNb + row_ * 1024; \
      lw0 = *(const u32x4*)(wb_ + woff); lw1 = *(const u32x4*)(wb_ + woff + 32768); \
      lq0 = *(const u32x4*)(qb_ + qkoff); lq1 = *(const u32x4*)(qb_ + qkoff + qkstep); \
      lk0 = *(const u32x4*)(kb_ + qkoff); lk1 = *(const u32x4*)(kb_ + qkoff + qkstep); \
      la0 = *(const u32x4*)(ACHp + (size_t)c_ * 4096); \
      gl_r = GCp[c_ * 64 + 63]; lg = *(const f32x4*)(GCp + c_ * 64 + goff); \
      if (wid < 4) { _Pragma("unroll") for (int jj = 0; jj < 4; ++jj) un[jj] = ub_[uoff + jj * 1024]; } } while (0)
#define SC_WRITE(bufp) do { char* bp_ = (bufp); float f_[8]; \
      *(u32x4*)(bp_ + WL + (r0 * 136 + c8) * 2) = lw0; *(u32x4*)(bp_ + WL + ((r0 + 32) * 136 + c8) * 2) = lw1; \
      *(u32x4*)(bp_ + QL + (r0 * 136 + c8) * 2) = lq0; *(u32x4*)(bp_ + QL + ((r0 + 32) * 136 + c8) * 2) = lq1; \
      unpack8(lk0, f_); _Pragma("unroll") for (int e = 0; e < 8; ++e) *(bf16_t*)(bp_ + KT + ((c8 + e) * 72 + ((r0 + c8) & 63)) * 2) = f2bf(f_[e]); \
      unpack8(lk1, f_); _Pragma("unroll") for (int e = 0; e < 8; ++e) *(bf16_t*)(bp_ + KT + ((c8 + e) * 72 + ((r0 + 32 + c8) & 63)) * 2) = f2bf(f_[e]); \
      *(u32x4*)(bp_ + AL + (arow * 72 + ac8) * 2) = la0; gend_cur = __expf(gl_r); \
      _Pragma("unroll") for (int jj = 0; jj < 4; ++jj) { uc[jj] = bf2f(un[jj]); fac[jj] = wid < 4 ? __expf(gl_r - lg[jj]) : __expf(lg[jj]); } } while (0)
    f32x4 S = {0, 0, 0, 0};
    for (int i = tid; i < 16 * 136 / 2; i += 512) ((unsigned*)ST)[i] = 0u;
    SC_LOAD(0); SC_WRITE(lds);
    SC_LOAD(1);
    __syncthreads();
    for (int c = 0; c < 260; ++c) {
      char* buf = lds + (c & 1) * BUFSZ;
      f32x4 acc = {0, 0, 0, 0};
      { const int ib = wid & 3; const char* ab = buf + (wid < 4 ? WL : QL);
        f32x4 acc1 = {0, 0, 0, 0};
#pragma unroll
        for (int kk = 0; kk < 4; ++kk) { const bf16x8 a = *(const bf16x8*)(ab + ((ib * 16 + fr) * 136 + kk * 32 + fq * 8) * 2); const bf16x8 bb = *(const bf16x8*)(ST + fr * 136 + kk * 32 + fq * 8);
          if (kk & 1) acc1 = __builtin_amdgcn_mfma_f32_16x16x32_bf16(a, bb, acc1, 0, 0, 0); else acc = __builtin_amdgcn_mfma_f32_16x16x32_bf16(a, bb, acc, 0, 0, 0); }
        acc += acc1;
        if (wid < 4) { float vn_[4];
#pragma unroll
          for (int jj = 0; jj < 4; ++jj) vn_[jj] = uc[jj] - acc[jj];
          u32x2 w; w.x = cvtpk(vn_[0], vn_[1]); w.y = cvtpk(vn_[2], vn_[3]); *(u32x2*)(VT + fr * 72 + ib * 16 + fq * 4) = w;
          w.x = cvtpk(vn_[0] * fac[0], vn_[1] * fac[1]); w.y = cvtpk(vn_[2] * fac[2], vn_[3] * fac[3]); *(u32x2*)(VT2 + fr * 72 + ib * 16 + fq * 4) = w; }
        else {
#pragma unroll
          for (int jj = 0; jj < 4; ++jj) acc[jj] *= fac[jj]; } }
      __syncthreads();
      { f32x4 sa = S * gend_cur, sb = {0, 0, 0, 0};
#pragma unroll
        for (int kk = 0; kk < 2; ++kk) { const bf16x8 a = *(const bf16x8*)(buf + KT + ((wid * 16 + fr) * 72 + ((kk * 32 + fq * 8 + ((wid * 16 + fr) & ~7)) & 63)) * 2); const bf16x8 bb = *(const bf16x8*)(VT2 + fr * 72 + kk * 32 + fq * 8);
          if (kk) sb = __builtin_amdgcn_mfma_f32_16x16x32_bf16(a, bb, sb, 0, 0, 0); else sa = __builtin_amdgcn_mfma_f32_16x16x32_bf16(a, bb, sa, 0, 0, 0); }
        sa += sb;
        S = sa; u32x2 w; w.x = cvtpk(S[0], S[1]); w.y = cvtpk(S[2], S[3]); *(u32x2*)(ST + fr * 136 + wid * 16 + fq * 4) = w; }
      if (wid >= 4) { const int ib = wid - 4;
#pragma unroll
        for (int kk = 0; kk < 2; ++kk) { const bf16x8 a = *(const bf16x8*)(buf + AL + ((ib * 16 + fr) * 72 + kk * 32 + fq * 8) * 2); const bf16x8 bb = *(const bf16x8*)(VT + fr * 72 + kk * 32 + fq * 8);
          acc = __builtin_amdgcn_mfma_f32_16x16x32_bf16(a, bb, acc, 0, 0, 0); }
        if (c >= 4) { bf16_t* ob_ = (bf16_t*)(p.ws + O_OSC) + ((size_t)(dir * 2 + b) * 16384 + (size_t)(c * 64 + ib * 16 + fq * 4 - 256)) * 1024 + h * 128 + slice * 16 + fr;
#pragma unroll
          for (int jj = 0; jj < 4; ++jj) ob_[jj * 1024] = f2bf(acc[jj]); } }
      if (c + 1 < 260) { SC_WRITE(lds + ((c + 1) & 1) * BUFSZ); }
      if (c + 2 < 260) SC_LOAD(c + 2);
      __syncthreads();
    }
#undef SC_LOAD
#undef SC_WRITE
  }
}

__device__ __forceinline__ float rope_apply(float y, int lane, int t) {
  const int i = lane & 15; const int pos = (lane < 32) ? (t >> 6) : (t & 63);
  const float inv = exp2f(-(float)i * (13.287712379549449f / 16.f));
  const float ang = (float)pos * inv; const float cs = __cosf(ang), sn = __sinf(ang);
  const float o = __shfl_xor(y, 16);
  return (lane & 16) ? (y * cs + o * sn) : (y * cs - o * sn);
}
__device__ __forceinline__ void phase_mlafin(CP& p, int wv_) {
  const int tid = TIDX, lane = tid & 63, gw = blockIdx.x * 8 + (tid >> 6), nw = gridDim.x * 8;
  const float* RSTD = (const float*)(p.ws + O_RSTD);
  constexpr int NQ = 32768 * 8, NK = 33280 * 8, NY = 32768, UB = 8;
  { const float* qn = p.in[I_QN]; const float n0 = qn[lane], n1 = qn[lane + 64], n2 = qn[lane + 128];
    for (int it0 = gw; it0 < NQ; it0 += UB * nw) {
      float y0[UB], y1[UB], y2[UB], rs[UB];
#pragma unroll
      for (int u = 0; u < UB; ++u) { const int it = min(it0 + u * nw, NQ - 1), row = it >> 3, h = it & 7;
        const bf16_t* src = (const bf16_t*)p.out + (size_t)row * 1536 + h * 192;
        y0[u] = bf2f(src[lane]); y1[u] = bf2f(src[lane + 64]); y2[u] = bf2f(src[lane + 128]); rs[u] = RSTD[row * 2]; }
#pragma unroll
      for (int u = 0; u < UB; ++u) { const int it = it0 + u * nw; if (it >= NQ) break; const int row = it >> 3, h = it & 7, b = row >> 14, t = row & 16383;
        float a0 = y0[u] * rs[u], a1 = y1[u] * rs[u], a2 = y2[u] * rs[u];
        float ss = a0 * a0 + a1 * a1 + a2 * a2;
#pragma unroll
        for (int o = 1; o < 64; o <<= 1) ss += __shfl_xor(ss, o);
        const float r = rsqrtf(ss * (1.f / 192.f) + EPS);
        a0 *= r * n0; a1 *= r * n1; a2 *= r * n2;
        a2 = rope_apply(a2, lane, t);
        bf16_t* dst = (bf16_t*)(p.ws + O_Q) + ((size_t)(b * 8 + h) * 16384 + t) * 192;
        dst[lane] = f2bf(a0); dst[lane + 64] = f2bf(a1); dst[lane + 128] = f2bf(a2); }
    } }
  { const float* kn = p.in[I_KNORM]; const float n0 = kn[lane], n1 = kn[lane + 64], n2 = kn[lane + 128];
    for (int it0 = gw; it0 < NK; it0 += UB * nw) {
      float y0[UB], y1[UB], y2[UB], rs[UB];
#pragma unroll
      for (int u = 0; u < UB; ++u) { const int it = min(it0 + u * nw, NK - 1), row = it >> 3, h = it & 7;
        const bf16_t* src = (const bf16_t*)(p.ws + O_KVRAW) + (size_t)row * 2048 + h * 256;
        y0[u] = bf2f(src[lane]); y1[u] = bf2f(src[lane + 64]);
        y2[u] = ((const float*)(p.ws + O_MISC))[(size_t)row * 96 + lane]; rs[u] = RSTD[row * 2 + 1]; }
#pragma unroll
      for (int u = 0; u < UB; ++u) { const int it = it0 + u * nw; if (it >= NK) break; const int row = it >> 3, h = it & 7; int b, pos, t = 0; const bool lat = row < 32768;
        if (lat) { b = row >> 14; t = row & 16383; pos = t; } else { b = (row - 32768) >> 8; pos = 16384 + ((row - 32768) & 255); }
        float a0 = y0[u] * rs[u], a1 = y1[u] * rs[u], a2 = y2[u];
        float ss = a0 * a0 + a1 * a1 + a2 * a2;
#pragma unroll
        for (int o = 1; o < 64; o <<= 1) ss += __shfl_xor(ss, o);
        const float r = rsqrtf(ss * (1.f / 192.f) + EPS);
        a0 *= r * n0; a1 *= r * n1; a2 *= r * n2;
        const float a2r = rope_apply(a2, lane, t); if (lat) a2 = a2r;
        bf16_t* dk = (bf16_t*)(p.ws + O_K) + ((size_t)(b * 8 + h) * 16640 + pos) * 192;
        dk[lane] = f2bf(a0); dk[lane + 64] = f2bf(a1); dk[lane + 128] = f2bf(a2);
        }
    } }
  { const int c0 = lane * 16; float on[16];
#pragma unroll
    for (int e = 0; e < 16; ++e) on[e] = p.in[I_ONORM][(c0 & 127) + e];
    for (int it0 = gw; it0 < NY; it0 += 2 * nw) {
      u32x4 wa[2][2], wb[2][2], wz[2][2];
#pragma unroll
      for (int u = 0; u < 2; ++u) { const int row = min(it0 + u * nw, NY - 1), b = row >> 14, t = row & 16383;
        const bf16_t* of = (const bf16_t*)(p.ws + O_OSC) + ((size_t)(0 * 2 + b) * 16384 + t) * 1024 + c0;
        const bf16_t* ob = (const bf16_t*)(p.ws + O_OSC) + ((size_t)(1 * 2 + b) * 16384 + (16383 - t)) * 1024 + c0;
        const bf16_t* zz = (const bf16_t*)(p.ws + O_ZG) + (size_t)row * 5120 + c0;
        wa[u][0] = *(const u32x4*)of; wa[u][1] = *(const u32x4*)(of + 8); wb[u][0] = *(const u32x4*)ob; wb[u][1] = *(const u32x4*)(ob + 8); wz[u][0] = *(const u32x4*)zz; wz[u][1] = *(const u32x4*)(zz + 8); }
#pragma unroll
      for (int u = 0; u < 2; ++u) { const int row = it0 + u * nw; if (row >= NY) break;
        float a[16], x[16], z[16];
        unpack8(wa[u][0], a); unpack8(wa[u][1], a + 8); unpack8(wb[u][0], x); unpack8(wb[u][1], x + 8); unpack8(wz[u][0], z); unpack8(wz[u][1], z + 8);
        float ss = 0.f;
#pragma unroll
        for (int e = 0; e < 16; ++e) { a[e] += x[e]; ss += a[e] * a[e]; }
        ss += __shfl_xor(ss, 1); ss += __shfl_xor(ss, 2); ss += __shfl_xor(ss, 4);
        const float r = rsqrtf(ss * (1.f / 128.f) + EPS);
#pragma unroll
        for (int e = 0; e < 16; ++e) a[e] = a[e] * r * on[e] * silu_f(z[e]);
        bf16_t* dst = (bf16_t*)((char*)p.out + DO_YCAT) + (size_t)row * 2048 + 1024 + c0;
        *(u32x4*)dst = pack8(a); *(u32x4*)(dst + 8) = pack8(a + 8); }
    } }
}

namespace att {
constexpr int NW = 8, QBLK = 32, KVBLK = 64, LDQ = 192, LDK = 192, LDV = 128;
constexpr float SCALE = 0.07216878364870323f, THR = 8.f;
constexpr int SHM_V = KVBLK * 128 * 2, SHM_K = KVBLK * 400;
#define KSWZ(row, colB) ((row) * 400 + (colB))
#define SBAR() __builtin_amdgcn_sched_barrier(0)
__device__ __forceinline__ int crow(int r, int hi) { return (r & 3) + 8 * (r >> 2) + 4 * hi; }
__device__ __forceinline__ void partialSM(f32x16& p0, f32x16& p1, float& m_reg, float& mn, float& alpha) {
  constexpr float C = SCALE * 1.4426950408889634f;
  float pmax = p0[0];
#pragma unroll
  for (int r = 1; r < 16; ++r) pmax = fmaxf(pmax, p0[r]);
#pragma unroll
  for (int r = 0; r < 16; ++r) pmax = fmaxf(pmax, p1[r]);
  { auto rr = __builtin_amdgcn_permlane32_swap(__float_as_uint(pmax), __float_as_uint(pmax), false, false);
    pmax = fmaxf(__uint_as_float(rr[0]), __uint_as_float(rr[1])); }
  if (__builtin_expect(__all(pmax - m_reg <= THR / SCALE), 1)) { mn = m_reg; alpha = 1.f; }
  else { mn = fmaxf(m_reg, pmax); alpha = __builtin_amdgcn_exp2f((m_reg - mn) * C); m_reg = mn; }
  const float mnC = -mn * C;
#pragma unroll
  for (int r = 0; r < 16; ++r) p0[r] = fmaf(p0[r], C, mnC);
#pragma unroll
  for (int r = 0; r < 16; ++r) p1[r] = fmaf(p1[r], C, mnC);
#pragma unroll
  for (int r = 0; r < 16; ++r) p0[r] = __builtin_amdgcn_exp2f(p0[r]);
}
__device__ __forceinline__ void finishSM(f32x16& p0, f32x16& p1, float alpha, float& l_reg, bf16x8& pa0, bf16x8& pa1, bf16x8& pa2, bf16x8& pa3) {
#pragma unroll
  for (int r = 0; r < 16; ++r) p1[r] = __builtin_amdgcn_exp2f(p1[r]);
  float ps = 0;
#pragma unroll
  for (int r = 0; r < 16; ++r) ps += p0[r];
#pragma unroll
  for (int r = 0; r < 16; ++r) ps += p1[r];
  { auto rr = __builtin_amdgcn_permlane32_swap(__float_as_uint(ps), __float_as_uint(ps), false, false);
    ps = __uint_as_float(rr[0]) + __uint_as_float(rr[1]); }
  l_reg = l_reg * alpha + ps;
#define PK4(PP, BASE, OUT) do { unsigned a0 = cvtpk(PP[BASE + 0], PP[BASE + 1]), a1 = cvtpk(PP[BASE + 2], PP[BASE + 3]);   \
    unsigned b0 = cvtpk(PP[BASE + 4], PP[BASE + 5]), b1 = cvtpk(PP[BASE + 6], PP[BASE + 7]);                              \
    auto r0 = __builtin_amdgcn_permlane32_swap(a0, b0, false, false); auto r1 = __builtin_amdgcn_permlane32_swap(a1, b1, false, false); \
    u32x4 w = {r0[0], r1[0], r0[1], r1[1]}; OUT = *reinterpret_cast<bf16x8*>(&w); } while (0)
  PK4(p0, 0, pa0); PK4(p0, 8, pa1); PK4(p1, 0, pa2); PK4(p1, 8, pa3);
#undef PK4
}
__device__ __forceinline__ void qkt(f32x16& p0, f32x16& p1, const char* Ks, const bf16x8* qr, const char* qlds, int r32, int hi) {
  p0 = f32x16{}; p1 = f32x16{};
#pragma unroll
  for (int d0 = 0; d0 < 12; ++d0) { const int cb = (d0 * 16 + hi * 8) * 2;
    const bf16x8 b0 = *reinterpret_cast<const bf16x8*>(Ks + KSWZ(r32, cb));
    const bf16x8 b1 = *reinterpret_cast<const bf16x8*>(Ks + KSWZ(32 + r32, cb));
    const bf16x8 qv = d0 < 8 ? qr[d0 < 8 ? d0 : 0] : *reinterpret_cast<const bf16x8*>(qlds + (d0 - 8) * 1024);
    p0 = __builtin_amdgcn_mfma_f32_32x32x16_bf16(b0, qv, p0, 0, 0, 0);
    p1 = __builtin_amdgcn_mfma_f32_32x32x16_bf16(b1, qv, p1, 0, 0, 0); }
}
__device__ __forceinline__ int v_st(int k, int c) { const int kk = (k & ~0xC) | ((k & 4) << 1) | ((k & 8) >> 1); return ((kk >> 3) * 4 + (c >> 5)) * 512 + ((kk & 7) * 32 + (c & 31)) * 2; }
__device__ __forceinline__ int v_rd_base(int lane) { return ((lane & 3) << 3) | (((lane >> 2) & 3) << 6) | (((lane >> 4) & 1) << 5) | (((lane >> 5) & 1) << 8); }
constexpr int v_rd_off(int d0, int ks, int half) { return d0 * 512 + ks * 4096 + half * 2048; }
template <int OFF> __device__ __forceinline__ s16x4 tr_read(int vb) {
  s16x4 r; asm volatile("ds_read_b64_tr_b16 %0, %1 offset:%2" : "=&v"(r) : "v"(vb), "i"(OFF) : "memory"); return r;
}
template <int D0> __device__ __forceinline__ void pv_one(f32x16& od, int vb, bf16x8 pa0, bf16x8 pa1, bf16x8 pa2, bf16x8 pa3) {
  const s16x4 l0 = tr_read<v_rd_off(D0, 0, 0)>(vb), h0 = tr_read<v_rd_off(D0, 0, 1)>(vb), l1 = tr_read<v_rd_off(D0, 1, 0)>(vb), h1 = tr_read<v_rd_off(D0, 1, 1)>(vb);
  const s16x4 l2 = tr_read<v_rd_off(D0, 2, 0)>(vb), h2 = tr_read<v_rd_off(D0, 2, 1)>(vb), l3 = tr_read<v_rd_off(D0, 3, 0)>(vb), h3 = tr_read<v_rd_off(D0, 3, 1)>(vb);
  asm volatile("s_waitcnt lgkmcnt(0)" ::: "memory"); SBAR();
#define PK(L, H) (bf16x8){L[0], L[1], L[2], L[3], H[0], H[1], H[2], H[3]}
  od = __builtin_amdgcn_mfma_f32_32x32x16_bf16(pa0, PK(l0, h0), od, 0, 0, 0);
  od = __builtin_amdgcn_mfma_f32_32x32x16_bf16(pa1, PK(l1, h1), od, 0, 0, 0);
  od = __builtin_amdgcn_mfma_f32_32x32x16_bf16(pa2, PK(l2, h2), od, 0, 0, 0);
  od = __builtin_amdgcn_mfma_f32_32x32x16_bf16(pa3, PK(l3, h3), od, 0, 0, 0);
#undef PK
}
__device__ __forceinline__ void pv_d0(f32x16* o, int vb, bf16x8 pa0, bf16x8 pa1, bf16x8 pa2, bf16x8 pa3) {
  pv_one<0>(o[0], vb, pa0, pa1, pa2, pa3); pv_one<1>(o[1], vb, pa0, pa1, pa2, pa3); pv_one<2>(o[2], vb, pa0, pa1, pa2, pa3); pv_one<3>(o[3], vb, pa0, pa1, pa2, pa3);
}
__device__ __forceinline__ void attn_body(const bf16_t* __restrict__ Qb, const bf16_t* __restrict__ Kh, const bf16_t* __restrict__ Vh, bf16_t* __restrict__ Ob, int seq, char* lds, int wv_) {
  const int tid = TIDX, wid = tid >> 6, lane = tid & 63, r32 = lane & 31, hi = lane >> 5;
  char* V_lds = lds; char* K_lds = lds + 2 * SHM_V;
  float* wsf = (float*)(lds + 2 * SHM_V + 2 * SHM_K) + wid * 64; float* li_l = wsf; float* al_l = wsf + 32;
  float m_reg = -1e30f, l_reg = 0; f32x16 o[4] = {}; bf16x8 qr[8];
  const int qoff = ((wid * QBLK + r32) * LDQ + hi * 8) * 2;
  const int qlo = 2 * SHM_V + 2 * SHM_K + 2048 + wid * 4096 + lane * 16;
#pragma unroll
  for (int d0 = 0; d0 < 8; ++d0) qr[d0] = *reinterpret_cast<const bf16x8*>((const char*)Qb + qoff + d0 * 32);
#pragma unroll
  for (int d0 = 8; d0 < 12; ++d0) *reinterpret_cast<bf16x8*>(lds + qlo + (d0 - 8) * 1024) = *reinterpret_cast<const bf16x8*>((const char*)Qb + qoff + d0 * 32);
  const int sr = tid >> 4, sc = (tid & 15) * 8, vst0 = v_st(sr, sc);
  const int kr0 = tid >> 3, kc0 = (tid & 7) * 8, ksw0 = KSWZ(kr0, kc0 * 2);
  const int vb0 = (int)(uintptr_t)V_lds + v_rd_base(lane);
  bf16x8 vs0, vs1, ks0, ks1, ks2;
  const int vo0 = (sr * LDV + sc) * 2, ko0 = (kr0 * LDK + kc0) * 2;
#define SLOAD(k0) do { const char* vt_ = (const char*)Vh + (size_t)(k0) * (LDV * 2); const char* kt_ = (const char*)Kh + (size_t)(k0) * (LDK * 2); \
    vs0 = *(const bf16x8*)(vt_ + vo0); vs1 = *(const bf16x8*)(vt_ + vo0 + 32 * LDV * 2); \
    ks0 = *(const bf16x8*)(kt_ + ko0); ks1 = *(const bf16x8*)(kt_ + ko0 + 128); ks2 = *(const bf16x8*)(kt_ + ko0 + 256); } while (0)
#define SWRITE(b) do { *(bf16x8*)(V_lds + (b) * SHM_V + vst0) = vs0; *(bf16x8*)(V_lds + (b) * SHM_V + vst0 + 8192) = vs1; \
    *(bf16x8*)(K_lds + (b) * SHM_K + ksw0) = ks0; *(bf16x8*)(K_lds + (b) * SHM_K + ksw0 + 128) = ks1; *(bf16x8*)(K_lds + (b) * SHM_K + ksw0 + 256) = ks2; } while (0)
#define SWAIT() asm volatile("s_waitcnt vmcnt(0)" ::: "memory")
#define RESC(a) do { if (__any((a) < 1.f)) { if (hi == 0) al_l[r32] = (a); asm volatile("s_waitcnt lgkmcnt(0)" ::: "memory"); \
    _Pragma("unroll") for (int d = 0; d < 4; ++d) _Pragma("unroll") for (int r = 0; r < 16; ++r) o[d][r] *= al_l[crow(r, hi)]; } } while (0)
  f32x16 pA0, pA1, pB0, pB1; float mnA, mnB, alA, alB; bf16x8 pa0, pa1, pa2, pa3; constexpr int NT = 260;
  SLOAD(0); SWAIT(); SWRITE(0); __syncthreads();
  qkt(pA0, pA1, K_lds, qr, lds + qlo, r32, hi); partialSM(pA0, pA1, m_reg, mnA, alA);
  SLOAD(KVBLK);
  SWAIT(); SWRITE(1); __syncthreads();
  for (int j = 1; j + 1 < NT; j += 2) {
    SBAR(); qkt(pB0, pB1, K_lds + SHM_K, qr, lds + qlo, r32, hi);
    finishSM(pA0, pA1, alA, l_reg, pa0, pa1, pa2, pa3); SBAR();
    SLOAD((j + 1) * KVBLK); SBAR();
    pv_d0(o, vb0, pa0, pa1, pa2, pa3); partialSM(pB0, pB1, m_reg, mnB, alB);
    __syncthreads(); SWAIT(); SWRITE(0);
    RESC(alB); __syncthreads();
    SBAR(); qkt(pA0, pA1, K_lds, qr, lds + qlo, r32, hi);
    finishSM(pB0, pB1, alB, l_reg, pa0, pa1, pa2, pa3); SBAR();
    SLOAD((j + 2) * KVBLK); SBAR();
    pv_d0(o, vb0 + SHM_V, pa0, pa1, pa2, pa3); partialSM(pA0, pA1, m_reg, mnA, alA);
    __syncthreads(); SWAIT(); SWRITE(1);
    RESC(alA); __syncthreads();
  }
  SBAR(); qkt(pB0, pB1, K_lds + SHM_K, qr, lds + qlo, r32, hi);
  finishSM(pA0, pA1, alA, l_reg, pa0, pa1, pa2, pa3); SBAR();
  pv_d0(o, vb0, pa0, pa1, pa2, pa3); partialSM(pB0, pB1, m_reg, mnB, alB);
  __syncthreads(); RESC(alB);
  finishSM(pB0, pB1, alB, l_reg, pa0, pa1, pa2, pa3); SBAR();
  pv_d0(o, vb0 + SHM_V, pa0, pa1, pa2, pa3);
  if (hi == 0) li_l[r32] = l_reg; asm volatile("s_waitcnt lgkmcnt(0)" ::: "memory");
  float rli[16];
#pragma unroll
  for (int r = 0; r < 16; ++r) rli[r] = __builtin_amdgcn_rcpf(li_l[crow(r, hi)]);
#pragma unroll
  for (int r = 0; r < 16; ++r) { const int ooff = ((wid * QBLK + crow(r, hi)) * 2048 + r32) * 2;
#pragma unroll
    for (int d0 = 0; d0 < 4; ++d0) *(bf16_t*)((char*)Ob + ooff + d0 * 64) = f2bf(o[d0][r] * rli[r]); }
  __syncthreads();
#undef SLOAD
#undef SWRITE
#undef SWAIT
#undef RESC
}
}

__device__ __forceinline__ void phase_attn(CP& p, char* lds, int wv_) {
  for (int u = blockIdx.x; u < 1024; u += gridDim.x) {
    const int qb = u & 63, bh = u >> 6, b = bh >> 3, h = bh & 7;
    const bf16_t* Q = (const bf16_t*)(p.ws + O_Q) + ((size_t)bh * 16384 + qb * 256) * 192;
    const bf16_t* K = (const bf16_t*)(p.ws + O_K) + (size_t)bh * 16640 * 192;
    const bf16_t* V = (const bf16_t*)(p.ws + O_V) + (size_t)bh * 16640 * 128;
    bf16_t* O = (bf16_t*)((char*)p.out + DO_YCAT) + ((size_t)b * 16384 + qb * 256) * 2048 + h * 128;
    att::attn_body(Q, K, V, O, 16640, lds, wv_);
  }
}

__device__ __forceinline__ void phase_glu(CP& p, int wv_) {
  bf16_t* H = (bf16_t*)(p.ws + O_H); const float* cw = p.in[I_FCONV]; const float* side = (const float*)(p.ws + O_SIDE);
  const int total = 2 * 512 * 5504;
  for (int id = blockIdx.x * 512 + TIDX; id < total; id += gridDim.x * 512) {
    const int type = id / (512 * 5504), rem = id - type * (512 * 5504), rb = rem / 5504, c = rem - rb * 5504;
    const int r = rb * 64 + (type ? 63 : 0), t = r & 16383;
    if (type == 0 ? (t == 0) : (t == 16383)) continue;
    const float* sp = side + ((size_t)(type * 512 + rb) * 3) * 5504 + c;
    const float gnb = type == 0 ? side[((size_t)(1 * 512 + rb - 1) * 3 + 2) * 5504 + c] : side[((size_t)(0 * 512 + rb + 1) * 3 + 2) * 5504 + c];
    const float cv = sp[0] + cw[(type ? 2 : 0) * 5504 + c] * gnb;
    H[(size_t)r * 5504 + c] = f2bf(silu_f(cv) * sp[5504]);
  }
}

#define XB_TMO      128
#define XB_XCNT(j)  (256  + 64 * (j))
#define XB_XSUB(j)  (1280 + 64 * (j))
#define XB_XGEN(j)  (2304 + 64 * (j))
#define XB_TOP      3328
#define XB_TOPGEN   3392
#define XCD_BAR_WORDS 3456
#define XB_SPIN_CAP (1u << 22)
__device__ __forceinline__ unsigned xb_ld(unsigned* p)              { return __hip_atomic_load(p, __ATOMIC_RELAXED, __HIP_MEMORY_SCOPE_AGENT); }
__device__ __forceinline__ unsigned xb_add(unsigned* p, unsigned v) { return __hip_atomic_fetch_add(p, v, __ATOMIC_RELAXED, __HIP_MEMORY_SCOPE_AGENT); }
__device__ __forceinline__ unsigned xb_xcc_id() { return (unsigned)__builtin_amdgcn_s_getreg((3 << 11) | 20) & 0xFu; }
#define XB_SPIN(cond, bar) do { unsigned _sp = 0; while (cond) { __builtin_amdgcn_s_sleep(1); \
    if ((++_sp & 255u) == 0u) { if (xb_ld(&(bar)[XB_TMO])) break; if (_sp > XB_SPIN_CAP) { atomicAdd(&(bar)[XB_TMO], 1u); break; } } } } while (0)
__device__ __forceinline__ void xcd_barrier_complete(unsigned* bar, unsigned x, unsigned& nloc, unsigned& nx) {
  const unsigned G = gridDim.x;
  unsigned sum, cnt, mine, sp = 0u;
  for (;;) {
    sum = 0u; cnt = 0u; mine = 0u;
#pragma unroll
    for (unsigned j = 0; j < 16; ++j) { const unsigned c = xb_ld(&bar[XB_XCNT(j)]); sum += c; cnt += (c > 0u) ? 1u : 0u; mine = (j == x) ? c : mine; }
    if (sum == G) break;
    __builtin_amdgcn_s_sleep(1);
    if ((++sp & 255u) == 0u) { if (xb_ld(&bar[XB_TMO])) break; if (sp > XB_SPIN_CAP) { atomicAdd(&bar[XB_TMO], 1u); break; } }
  }
  nloc = mine > 0u ? mine : 1u; nx = cnt > 0u ? cnt : 1u;
}
__device__ __forceinline__ void gsync(unsigned* bar, unsigned xcc, volatile LAS unsigned* st, int wv_) {
  asm volatile("s_waitcnt vmcnt(0)" ::: "memory");
  __syncthreads();
  if (wv_ == 0 && lane_id_v() == 0) {
    __builtin_amdgcn_s_waitcnt(0);
    unsigned nloc = st[0], nx = st[1];
    if (nloc == 0u) { xcd_barrier_complete(bar, xcc, nloc, nx); st[0] = nloc; st[1] = nx; }
    const unsigned old = xb_add(&bar[XB_XSUB(xcc)], 1u);
    const unsigned gen = old / nloc;
    if (old + 1u == (gen + 1u) * nloc) {
      __builtin_amdgcn_fence(__ATOMIC_RELEASE, "agent");
      asm volatile("s_waitcnt vmcnt(0)" ::: "memory");
      const unsigned og = xb_add(&bar[XB_TOP], 1u);
      const unsigned tg = og / nx;
      if (og + 1u == (tg + 1u) * nx) xb_add(&bar[XB_TOPGEN], 1u);
      else XB_SPIN(xb_ld(&bar[XB_TOPGEN]) == tg, bar);
      __builtin_amdgcn_fence(__ATOMIC_ACQUIRE, "agent");
      xb_add(&bar[XB_XGEN(xcc)], 1u);
      asm volatile("s_waitcnt vmcnt(0)" ::: "memory");
    } else {
      XB_SPIN(xb_ld(&bar[XB_XGEN(xcc)]) == gen, bar);
      __builtin_amdgcn_fence(__ATOMIC_ACQUIRE, "agent");
      asm volatile("s_waitcnt vmcnt(0)" ::: "memory");
    }
  }
  __syncthreads();
}

#if DBG
__device__ __forceinline__ void chk16(const void* ptr, size_t nelem, unsigned* flag, unsigned code, int wv_) {
  const u32x4* q = (const u32x4*)ptr; const size_t n = nelem / 8; bool bad = false;
  for (size_t i = (size_t)blockIdx.x * 512 + TIDX; i < n; i += (size_t)gridDim.x * 512) { const u32x4 w = q[i];
#pragma unroll
    for (int e = 0; e < 4; ++e) { const unsigned a = w[e] & 0x7F80u, b = (w[e] >> 16) & 0x7F80u; if (a >= (141u << 7) || b >= (141u << 7)) bad = true; } }
  if (bad) atomicMax(flag, 32u - code);
}
__device__ __forceinline__ void chk32(const void* ptr, size_t nelem, unsigned* flag, unsigned code, int wv_) {
  const unsigned* q = (const unsigned*)ptr; bool bad = false;
  for (size_t i = (size_t)blockIdx.x * 512 + TIDX; i < nelem; i += (size_t)gridDim.x * 512) { const unsigned a = (q[i] >> 23) & 0xFFu; if (a >= 141u) bad = true; }
  if (bad) atomicMax(flag, 32u - code);
}
__device__ void dbg_check(CP& p, int ph, int wv_) {
  unsigned* flag = (unsigned*)(p.ws + O_BAR) + 16; char* ws = p.ws;
  switch (ph) {
    case 0: chk32(ws + O_MOD, 36864, flag, 1, wv_); chk16(ws + O_WIN, 9472ull * 2048, flag, 1, wv_); chk16(ws + O_WUP, 11008ull * 2048, flag, 1, wv_); chk16(ws + O_WDN, 2048ull * 5504, flag, 1, wv_); chk16(ws + O_WQB, (O_WUP - O_WQB) / 2, flag, 1, wv_); break;
    case 1: chk16(ws + O_XN, NROW * 2048, flag, 2, wv_); break;
    case 2: chk16(ws + O_QKVA, NROW * 1024, flag, 3, wv_); chk16(ws + O_DQKV, NROW * 3072, flag, 3, wv_); chk16(ws + O_ZG, NROW * 5120, flag, 3, wv_); chk32(ws + O_MISC, NROW * 96, flag, 3, wv_); break;
    case 3: chk16(ws + O_QN, NLAT * 1024, flag, 4, wv_); chk16(ws + O_KN, NROW * 1024, flag, 4, wv_); chk16(ws + O_VN, NROW * 1024, flag, 4, wv_); chk32(ws + O_G, 2ull * 2 * 8 * 16640 * 2, flag, 4, wv_); chk32(ws + O_RSTD, NROW * 2, flag, 4, wv_); break;
    case 4: chk16(p.out, 4ull * 32768 * 1024, flag, 5, wv_); chk16(ws + O_UC, 2ull * 2 * 2 * 256 * 1024, flag, 5, wv_); chk32(ws + O_GC, 2ull * 2 * 8 * 16640, flag, 5, wv_); break;
    case 5: { const u32x4* q = (const u32x4*)(ws + O_OSC); const size_t n = 2ull * 32768 * 1024 / 8; unsigned cnt = 0, mn = 0xFFFFFFFFu;
      for (size_t i = (size_t)blockIdx.x * 512 + TIDX; i < n; i += (size_t)gridDim.x * 512) { const u32x4 w = q[i];
        for (int e = 0; e < 4; ++e) { const unsigned a = w[e] & 0x7F80u, b = (w[e] >> 16) & 0x7F80u; if (a >= (141u << 7)) { cnt++; mn = min(mn, (unsigned)(i * 8 + e * 2)); } if (b >= (141u << 7)) { cnt++; mn = min(mn, (unsigned)(i * 8 + e * 2 + 1)); } } }
      if (cnt) { atomicMax(flag, 32u - 6u); atomicAdd(flag + 4, cnt); atomicMax(flag + 5, 0xFFFFFFFFu - mn); } } break;
    case 6: chk16(p.out, NLAT * 1536, flag, 7, wv_); chk16(ws + O_KVRAW, NROW * 2048, flag, 7, wv_); break;
    case 7: chk16(ws + O_Q, 2ull * 8 * 16384 * 192, flag, 8, wv_); chk16(ws + O_K, 2ull * 8 * 16640 * 192, flag, 8, wv_); chk16(ws + O_V, 2ull * 8 * 16640 * 128, flag, 8, wv_); break;
    case 8: chk16((char*)p.out + DO_YCAT, NLAT * 2048, flag, 9, wv_); break;
    case 9: chk16(ws + O_MERGED, NLAT * 2048, flag, 10, wv_); break;
    case 10: chk32(p.out, NLAT * 2048, flag, 11, wv_); break;
    case 11: chk16(ws + O_XN2, NLAT * 2048, flag, 12, wv_); break;
    case 12: chk16(ws + O_H, NLAT * 11008, flag, 13, wv_); break;
    case 13: chk16(ws + O_H, NLAT * 11008, flag, 14, wv_); break;
    case 14: chk32(p.out, NLAT * 2048, flag, 15, wv_); break;
  }
}
#endif
__global__ void __launch_bounds__(512) mega(P p_unused, int ph_lo, int ph_hi) {
  extern __shared__ __attribute__((aligned(16))) unsigned char lds_raw[];
  LAS unsigned char* ldsl = (LAS unsigned char*)lds_raw; char* lds = (char*)lds_raw;
  cg::grid_group grid = cg::this_grid();
  const int wv_ = __builtin_amdgcn_readfirstlane((int)(threadIdx.x >> 6));
  volatile LAS unsigned* xst_ = (volatile LAS unsigned*)(ldsl + 143344);
  const unsigned xcc_ = xb_xcc_id();
  if (threadIdx.x == 0) { xst_[0] = 0u; xst_[1] = 0u; (void)xb_add((unsigned*)(p_unused.ws + O_BAR) + XB_XCNT(xcc_), 1u); }
  __syncthreads();
  CP* kp0 = (CP*)__builtin_amdgcn_kernarg_segment_ptr();
#define PP() (*({ CP* q_ = kp0; asm volatile("" : "+s"(q_)); q_; }))
  if (ph_lo <= 0 && 0 <= ph_hi) { CP& p = PP(); phase_prep(p, lds, wv_); if (REP == 0) { phase_prep(p, lds, wv_, 384); } if (0 < ph_hi) grid.sync(); }
#if DBG
  { gsync((unsigned*)(PP().ws + O_BAR) + 32, (unsigned)(2 * 0 + 1) * gridDim.x, wv_); CP& p = PP(); dbg_check(p, 0, wv_); gsync((unsigned*)(PP().ws + O_BAR) + 32, (unsigned)(2 * 0 + 2) * gridDim.x, wv_); }
#endif
  if (ph_lo <= 1 && 1 <= ph_hi) { CP& p = PP(); phase_normmod<0>(p, wv_); if (REP == 1) { phase_normmod<0>(p, wv_); } if (1 < ph_hi) gsync((unsigned*)(PP().ws + O_BAR), xcc_, xst_, wv_); }
#if DBG
  { gsync((unsigned*)(PP().ws + O_BAR) + 32, (unsigned)(2 * 1 + 1) * gridDim.x, wv_); CP& p = PP(); dbg_check(p, 1, wv_); gsync((unsigned*)(PP().ws + O_BAR) + 32, (unsigned)(2 * 1 + 2) * gridDim.x, wv_); }
#endif
  if (ph_lo <= 2 && 2 <= ph_hi) { CP& p = PP(); { gm::JobInproj J; J.A = p.ws + O_XN; J.B = p.ws + O_WIN; J.K = 2048; J.lda = 2048; J.ldb = 2048; J.nM = 130; J.nN = 37; J.ws = p.ws; gm::gemm_phase(ldsl, J, wv_); } if (REP == 2) { { gm::JobInproj J; J.A = p.ws + O_XN; J.B = p.ws + O_WIN; J.K = 2048; J.lda = 2048; J.ldb = 2048; J.nM = 130; J.nN = 37; J.ws = p.ws; gm::gemm_phase(ldsl, J, wv_); } } if (2 < ph_hi) gsync((unsigned*)(PP().ws + O_BAR), xcc_, xst_, wv_); }
#if DBG
  { gsync((unsigned*)(PP().ws + O_BAR) + 32, (unsigned)(2 * 2 + 1) * gridDim.x, wv_); CP& p = PP(); dbg_check(p, 2, wv_); gsync((unsigned*)(PP().ws + O_BAR) + 32, (unsigned)(2 * 2 + 2) * gridDim.x, wv_); }
#endif
  if (ph_lo <= 3 && 3 <= ph_hi) { CP& p = PP(); phase_dnprep(p, wv_); if (REP == 3) { phase_dnprep(p, wv_); } if (3 < ph_hi) gsync((unsigned*)(PP().ws + O_BAR), xcc_, xst_, wv_); }
#if DBG
  { gsync((unsigned*)(PP().ws + O_BAR) + 32, (unsigned)(2 * 3 + 1) * gridDim.x, wv_); CP& p = PP(); dbg_check(p, 3, wv_); gsync((unsigned*)(PP().ws + O_BAR) + 32, (unsigned)(2 * 3 + 2) * gridDim.x, wv_); }
#endif
  if (ph_lo <= 4 && 4 <= ph_hi) { CP& p = PP(); phase_chunk(p, lds, wv_); if (REP == 4) { phase_chunk(p, lds, wv_); } if (4 < ph_hi) gsync((unsigned*)(PP().ws + O_BAR), xcc_, xst_, wv_); }
#if DBG
  { gsync((unsigned*)(PP().ws + O_BAR) + 32, (unsigned)(2 * 4 + 1) * gridDim.x, wv_); CP& p = PP(); dbg_check(p, 4, wv_); gsync((unsigned*)(PP().ws + O_BAR) + 32, (unsigned)(2 * 4 + 2) * gridDim.x, wv_); }
#endif
  if (ph_lo <= 5 && 5 <= ph_hi) { CP& p = PP(); phase_scan(p, lds, wv_); if (REP == 5) { phase_scan(p, lds, wv_); } if (5 < ph_hi) gsync((unsigned*)(PP().ws + O_BAR), xcc_, xst_, wv_); }
#if DBG
  { gsync((unsigned*)(PP().ws + O_BAR) + 32, (unsigned)(2 * 5 + 1) * gridDim.x, wv_); CP& p = PP(); dbg_check(p, 5, wv_); gsync((unsigned*)(PP().ws + O_BAR) + 32, (unsigned)(2 * 5 + 2) * gridDim.x, wv_); }
#endif
  if (ph_lo <= 6 && 6 <= ph_hi) { CP& p = PP(); { gm::JobPlain J; J.A = p.ws + O_QKVA; J.B = p.ws + O_WQB; J.K = 512; J.lda = 1024; J.ldb = 512; J.nM = 128; J.nN = 6; J.O = (bf16_t*)p.out; J.ldc = 1536; gm::gemm_phase(ldsl, J, wv_);
#if DBG
  { gsync((unsigned*)(PP().ws + O_BAR) + 32, (unsigned)(2 * 6 + 1) * gridDim.x, wv_); CP& p = PP(); dbg_check(p, 6, wv_); gsync((unsigned*)(PP().ws + O_BAR) + 32, (unsigned)(2 * 6 + 2) * gridDim.x, wv_); }
#endif
                gm::JobKV J2; J2.A = p.ws + O_QKVA + 1024; J2.B = p.ws + O_WKVB; J2.K = 512; J2.lda = 1024; J2.ldb = 512; J2.nM = 130; J2.nN = 8; J2.O = (bf16_t*)(p.ws + O_KVRAW); J2.V = (bf16_t*)(p.ws + O_V); J2.rstd = (const float*)(p.ws + O_RSTD); gm::gemm_phase(ldsl, J2, wv_); } if (6 < ph_hi) gsync((unsigned*)(PP().ws + O_BAR), xcc_, xst_, wv_); }
  if (ph_lo <= 7 && 7 <= ph_hi) { CP& p = PP(); phase_mlafin(p, wv_); if (REP == 7) { phase_mlafin(p, wv_); } if (7 < ph_hi) gsync((unsigned*)(PP().ws + O_BAR), xcc_, xst_, wv_); }
#if DBG
  { gsync((unsigned*)(PP().ws + O_BAR) + 32, (unsigned)(2 * 7 + 1) * gridDim.x, wv_); CP& p = PP(); dbg_check(p, 7, wv_); gsync((unsigned*)(PP().ws + O_BAR) + 32, (unsigned)(2 * 7 + 2) * gridDim.x, wv_); }
#endif
  if (ph_lo <= 8 && 8 <= ph_hi) { CP& p = PP(); phase_attn(p, lds, wv_); if (REP == 8) { phase_attn(p, lds, wv_); } if (8 < ph_hi) gsync((unsigned*)(PP().ws + O_BAR), xcc_, xst_, wv_); }
#if DBG
  { gsync((unsigned*)(PP().ws + O_BAR) + 32, (unsigned)(2 * 8 + 1) * gridDim.x, wv_); CP& p = PP(); dbg_check(p, 8, wv_); gsync((unsigned*)(PP().ws + O_BAR) + 32, (unsigned)(2 * 8 + 2) * gridDim.x, wv_); }
#endif
  if (ph_lo <= 9 && 9 <= ph_hi) { CP& p = PP(); { gm::JobMerge J; J.A = (const char*)p.out + DO_YCAT; J.B = p.ws + O_WCAT; J.K = 1024; J.lda = 2048; J.ldb = 2048; J.nM = 128; J.nN = 8; J.ZG = (const bf16_t*)(p.ws + O_ZG); J.O = (bf16_t*)(p.ws + O_MERGED); gm::gemm_phase(ldsl, J, wv_); } if (REP == 9) { { gm::JobMerge J; J.A = (const char*)p.out + DO_YCAT; J.B = p.ws + O_WCAT; J.K = 1024; J.lda = 2048; J.ldb = 2048; J.nM = 128; J.nN = 8; J.ZG = (const bf16_t*)(p.ws + O_ZG); J.O = (bf16_t*)(p.ws + O_MERGED); gm::gemm_phase(ldsl, J, wv_); } } if (9 < ph_hi) gsync((unsigned*)(PP().ws + O_BAR), xcc_, xst_, wv_); }
#if DBG
  { gsync((unsigned*)(PP().ws + O_BAR) + 32, (unsigned)(2 * 9 + 1) * gridDim.x, wv_); CP& p = PP(); dbg_check(p, 9, wv_); gsync((unsigned*)(PP().ws + O_BAR) + 32, (unsigned)(2 * 9 + 2) * gridDim.x, wv_); }
#endif
  if (ph_lo <= 10 && 10 <= ph_hi) { CP& p = PP(); { gm::JobResid J; J.A = p.ws + O_MERGED; J.B = p.ws + O_WOUT; J.K = 2048; J.lda = 2048; J.ldb = 2048; J.nM = 128; J.nN = 8; J.base = p.in[I_X]; J.gate = (const float*)(p.ws + O_MOD) + 2 * 2048; J.out = p.out; gm::gemm_phase(ldsl, J, wv_); } if (REP == 10) { { gm::JobResid J; J.A = p.ws + O_MERGED; J.B = p.ws + O_WOUT; J.K = 2048; J.lda = 2048; J.ldb = 2048; J.nM = 128; J.nN = 8; J.base = p.in[I_X]; J.gate = (const float*)(p.ws + O_MOD) + 2 * 2048; J.out = p.out; gm::gemm_phase(ldsl, J, wv_); } } if (10 < ph_hi) gsync((unsigned*)(PP().ws + O_BAR), xcc_, xst_, wv_); }
#if DBG
  { gsync((unsigned*)(PP().ws + O_BAR) + 32, (unsigned)(2 * 10 + 1) * gridDim.x, wv_); CP& p = PP(); dbg_check(p, 10, wv_); gsync((unsigned*)(PP().ws + O_BAR) + 32, (unsigned)(2 * 10 + 2) * gridDim.x, wv_); }
#endif
  if (ph_lo <= 11 && 11 <= ph_hi) { CP& p = PP(); phase_normmod<1>(p, wv_); if (REP == 11) { phase_normmod<1>(p, wv_); } if (11 < ph_hi) gsync((unsigned*)(PP().ws + O_BAR), xcc_, xst_, wv_); }
#if DBG
  { gsync((unsigned*)(PP().ws + O_BAR) + 32, (unsigned)(2 * 11 + 1) * gridDim.x, wv_); CP& p = PP(); dbg_check(p, 11, wv_); gsync((unsigned*)(PP().ws + O_BAR) + 32, (unsigned)(2 * 11 + 2) * gridDim.x, wv_); }
#endif
  if (ph_lo <= 12 && 12 <= ph_hi) { CP& p = PP(); { gm::JobUpGlu J; J.A = p.ws + O_XN2; J.B = p.ws + O_WUP; J.K = 2048; J.lda = 2048; J.ldb = 2048; J.nM = 128; J.nN = 43; J.O = (bf16_t*)(p.ws + O_H); J.cw = p.in[I_FCONV]; J.side = (float*)(p.ws + O_SIDE); gm::gemm_phase(ldsl, J, wv_); } if (REP == 12) { { gm::JobUpGlu J; J.A = p.ws + O_XN2; J.B = p.ws + O_WUP; J.K = 2048; J.lda = 2048; J.ldb = 2048; J.nM = 128; J.nN = 43; J.O = (bf16_t*)(p.ws + O_H); J.cw = p.in[I_FCONV]; J.side = (float*)(p.ws + O_SIDE); gm::gemm_phase(ldsl, J, wv_); } } if (12 < ph_hi) gsync((unsigned*)(PP().ws + O_BAR), xcc_, xst_, wv_); }
#if DBG
  { gsync((unsigned*)(PP().ws + O_BAR) + 32, (unsigned)(2 * 12 + 1) * gridDim.x, wv_); CP& p = PP(); dbg_check(p, 12, wv_); gsync((unsigned*)(PP().ws + O_BAR) + 32, (unsigned)(2 * 12 + 2) * gridDim.x, wv_); }
#endif
  if (ph_lo <= 13 && 13 <= ph_hi) { CP& p = PP(); phase_glu(p, wv_); if (REP == 13) { phase_glu(p, wv_); } if (13 < ph_hi) gsync((unsigned*)(PP().ws + O_BAR), xcc_, xst_, wv_); }
#if DBG
  { gsync((unsigned*)(PP().ws + O_BAR) + 32, (unsigned)(2 * 13 + 1) * gridDim.x, wv_); CP& p = PP(); dbg_check(p, 13, wv_); gsync((unsigned*)(PP().ws + O_BAR) + 32, (unsigned)(2 * 13 + 2) * gridDim.x, wv_); }
#endif
  if (ph_lo <= 14 && 14 <= ph_hi) { CP& p = PP(); { gm::JobResid J; J.A = p.ws + O_H; J.B = p.ws + O_WDN; J.K = 5504; J.lda = 5504; J.ldb = 5504; J.nM = 128; J.nN = 8; J.base = p.out; J.gate = (const float*)(p.ws + O_MOD) + 5 * 2048; J.out = p.out; gm::gemm_phase(ldsl, J, wv_); } if (REP == 14) { { gm::JobResid J; J.A = p.ws + O_H; J.B = p.ws + O_WDN; J.K = 5504; J.lda = 5504; J.ldb = 5504; J.nM = 128; J.nN = 8; J.base = p.out; J.gate = (const float*)(p.ws + O_MOD) + 5 * 2048; J.out = p.out; gm::gemm_phase(ldsl, J, wv_); } } if (14 < ph_hi) gsync((unsigned*)(PP().ws + O_BAR), xcc_, xst_, wv_); }
#if DBG
  { gsync((unsigned*)(PP().ws + O_BAR) + 32, (unsigned)(2 * 14 + 1) * gridDim.x, wv_); CP& p = PP(); dbg_check(p, 14, wv_); gsync((unsigned*)(PP().ws + O_BAR) + 32, (unsigned)(2 * 14 + 2) * gridDim.x, wv_); }
#endif
#if DBG
  { CP& p = PP(); const unsigned f = __hip_atomic_load((unsigned*)(p.ws + O_BAR) + 16, __ATOMIC_RELAXED, __HIP_MEMORY_SCOPE_AGENT);
    if (f) { float val = 1000.f * (float)(32u - f);
      if (32u - f == 6u) { const unsigned* fw = (const unsigned*)(p.ws + O_BAR) + 17; float dg[3];
        for (int q = 0; q < 3; ++q) { const unsigned w = __hip_atomic_load(fw + q, __ATOMIC_RELAXED, __HIP_MEMORY_SCOPE_AGENT); const int c = w ? 1000 - (int)w : -1;
          dg[q] = c < 0 ? 0.f : (c < 4 ? 1.f : (c < 8 ? 2.f : (c < 16 ? 3.f : (c < 32 ? 4.f : (c < 64 ? 5.f : (c < 128 ? 6.f : 7.f)))))); }
        val = 1000.f + 100.f * ((dg[0] > 0.f ? 4.f : 0.f) + (dg[1] > 0.f ? 2.f : 0.f) + (dg[2] > 0.f ? 1.f : 0.f));
        for (size_t i = (size_t)blockIdx.x * 512 + TIDX; i < NLAT * 2048; i += (size_t)gridDim.x * 512) p.out[i] = val; return; } for (size_t i = (size_t)blockIdx.x * 512 + TIDX; i < NLAT * 2048; i += (size_t)gridDim.x * 512) p.out[i] = val; } }
#endif
}

extern "C" void kernel_launch(void* const* d_in, const int* in_sizes, int n_in, void* d_out, int out_size, void* d_ws, size_t ws_size, hipStream_t stream) {
  static int grid = 0;
  if (grid == 0) {
    if (n_in != 25 || out_size != 32768 * 2048 || ws_size < O_END) { fprintf(stderr, "kernel_launch: unexpected shapes (n_in %d out %d ws %zu need %zu)\n", n_in, out_size, ws_size, (size_t)O_END); grid = -1; return; }
    int dev = 0, cus = 0, per_cu = 0;
    hipGetDevice(&dev); hipDeviceGetAttribute(&cus, hipDeviceAttributeMultiprocessorCount, dev);
    if (hipFuncSetAttribute((const void*)mega, hipFuncAttributeMaxDynamicSharedMemorySize, LDS_BYTES) != hipSuccess) { fprintf(stderr, "kernel_launch: hipFuncSetAttribute failed\n"); grid = -1; return; }
    if (hipOccupancyMaxActiveBlocksPerMultiprocessor(&per_cu, (const void*)mega, 512, LDS_BYTES) != hipSuccess || per_cu < 1) { fprintf(stderr, "kernel_launch: occupancy query says %d\n", per_cu); per_cu = 1; }
    (void)hipGetLastError();
    grid = cus;
  }
  if (grid < 0) return;
  (void)hipMemsetAsync((char*)d_ws + O_MOD, 0, 3 * 12288 * 4 + 16384, stream);
  P p{};
  for (int i = 0; i < 25; ++i) p.in[i] = (const float*)d_in[i];
  p.out = (float*)d_out; p.ws = (char*)d_ws;
#if N_LAUNCH_PER_PHASE
  for (int ph = 0; ph < NPHASE; ++ph) { int lo = ph, hi = ph; void* args[] = {&p, &lo, &hi};
    hipLaunchCooperativeKernel((const void*)mega, dim3(grid), dim3(512), args, LDS_BYTES, stream); }
#else
  int lo = 0, hi = NPHASE - 1; void* args[] = {&p, &lo, &hi};
  hipError_t e = hipLaunchCooperativeKernel((const void*)mega, dim3(grid), dim3(512), args, LDS_BYTES, stream);
  if (e != hipSuccess) fprintf(stderr, "cooperative launch failed: %s (grid %d)\n", hipGetErrorString(e), grid);
#endif
}
```
